# Optimizing an MI355X kernel written in HIP

```python
import math
import jax, jax.numpy as jnp
from jax import lax
import numpy as np

D_MODEL = 1024
BATCH = 32
SEQ = 256
DEPTH = 4
DEC_BATCH = 8
DEC_SEQ = 2048
PAST_LEN = 256

GRID_W = 64
BLK = 128
WINDOW = 128
ROPE_BASE = 10000.0
EPS = 1e-6
NEG_INF = -1e30
D_MIX = D_MODEL
A_WIDTH = D_MIX // 2
B_WIDTH = D_MIX // 4
C_WIDTH = D_MIX // 4
A_HEADS = 4
A_V_DIM = A_WIDTH // A_HEADS
A_QK_DIM = A_V_DIM // 2
B_HEADS = 4
B_KV_HEADS = 2
B_GROUP = B_HEADS // B_KV_HEADS
B_HEAD_DIM = B_WIDTH // B_HEADS
C_GROUPS = 4
C_GROUP_DIM = C_WIDTH // C_GROUPS
A_Q_COLS = A_HEADS * 2 * A_QK_DIM
A_K_COLS = A_HEADS * 2 * A_QK_DIM
A_V_COLS = A_HEADS * A_V_DIM
B_Q_COLS = B_HEADS * B_HEAD_DIM
B_KV_COLS = B_KV_HEADS * B_HEAD_DIM
GATE_COLS = D_MIX
IN_COLS = A_Q_COLS + A_K_COLS + A_V_COLS + B_Q_COLS + 2 * B_KV_COLS + C_WIDTH + GATE_COLS

kernel_name = "hybrid_diffattn_swa_fourier_prefix_dit_step"


def split_points():
    sizes = [A_Q_COLS, A_K_COLS, A_V_COLS, B_Q_COLS, B_KV_COLS, B_KV_COLS, C_WIDTH]
    return [int(v) for v in np.cumsum(sizes)]


def rms_norm(x, g):
    xf = x.astype(jnp.float32)
    y = xf * lax.rsqrt(jnp.mean(xf * xf, axis=-1, keepdims=True) + EPS)
    return (y * g.astype(jnp.float32)).astype(x.dtype)


def axial_rope_tables(n_tokens, dim, dtype):
    rows = n_tokens // GRID_W
    row = jnp.repeat(jnp.arange(rows), GRID_W).astype(jnp.float32)
    col = jnp.tile(jnp.arange(GRID_W), rows).astype(jnp.float32)
    nf = dim // 4
    inv = ROPE_BASE ** (-jnp.arange(nf, dtype=jnp.float32) / nf)
    ar = row[:, None] * inv
    ac = col[:, None] * inv
    ang = jnp.concatenate([ar, ar, ac, ac], axis=-1)
    return jnp.cos(ang).astype(dtype), jnp.sin(ang).astype(dtype)


def apply_rope(x, cos, sin):
    d = x.shape[-1]
    shape = (x.shape[1],) + (1,) * (x.ndim - 3) + (d,)
    c = cos.reshape(shape)
    s = sin.reshape(shape)
    x1a, x1b, x2a, x2b = jnp.split(x, 4, axis=-1)
    rot = jnp.concatenate([-x1b, x1a, -x2b, x2a], axis=-1)
    return x * c + rot * s


def diff_attention(q, k, v, lam):
    b, sq, h, _, dk = q.shape
    nb = sq // BLK
    qb = jnp.moveaxis(q.reshape(b, nb, BLK, h, 2, dk), 1, 0)
    scale = dk ** -0.5

    def one(qblk):
        s = jnp.einsum('bqhcd,bkhcd->bhcqk', qblk, k).astype(jnp.float32) * scale
        p = jax.nn.softmax(s, axis=-1)
        w = p[:, :, 0] - lam * p[:, :, 1]
        return jnp.einsum('bhqk,bkhd->bqhd', w.astype(v.dtype), v)

    o = lax.map(one, qb)
    return jnp.moveaxis(o, 0, 1).reshape(b, sq, h, v.shape[-1])


def sink_attention(q, k, v, sink):
    b, sq, kvh, g, d = q.shape
    nb = sq // BLK
    qb = jnp.moveaxis(q.reshape(b, nb, BLK, kvh, g, d), 1, 0)
    scale = d ** -0.5

    def one(qblk):
        s = jnp.einsum('bqkgd,bjkd->bkgqj', qblk, k).astype(jnp.float32) * scale
        sk = jnp.broadcast_to(sink.astype(jnp.float32)[None, :, :, None, None], s.shape[:-1] + (1,))
        p = jax.nn.softmax(jnp.concatenate([s, sk], axis=-1), axis=-1)[..., :-1]
        return jnp.einsum('bkgqj,bjkd->bqkgd', p.astype(v.dtype), v)

    o = lax.map(one, qb)
    return jnp.moveaxis(o, 0, 1).reshape(b, sq, kvh * g * d)


def banded_sink_attention(q, k, v, kc, vc, sink):
    b, s_len, kvh, g, d = q.shape
    nb = s_len // BLK
    qb = q.reshape(b, nb, BLK, kvh, g, d)

    def windows(t):
        tb = t.reshape(b, nb, BLK, kvh, d)
        tp = jnp.pad(tb, ((0, 0), (1, 1), (0, 0), (0, 0), (0, 0)))
        return jnp.concatenate([tp[:, :-2], tp[:, 1:-1], tp[:, 2:]], axis=2)

    kw, vw = windows(k), windows(v)
    scale = d ** -0.5
    s_loc = jnp.einsum('bnqkgd,bnjkd->bnkgqj', qb, kw).astype(jnp.float32) * scale
    blk = jnp.arange(nb)[:, None, None]
    qa = jnp.arange(BLK)[None, :, None]
    kj = jnp.arange(3 * BLK)[None, None, :]
    kpos = blk * BLK + kj - BLK
    qpos = blk * BLK + qa
    valid = (jnp.abs(kpos - qpos) <= WINDOW) & (kpos >= 0) & (kpos < s_len)
    s_loc = jnp.where(valid[None, :, None, None], s_loc, NEG_INF)
    s_ctx = jnp.einsum('bnqkgd,bjkd->bnkgqj', qb, kc).astype(jnp.float32) * scale
    sk = jnp.broadcast_to(sink.astype(jnp.float32)[None, None, :, :, None, None], s_loc.shape[:-1] + (1,))
    p = jax.nn.softmax(jnp.concatenate([s_loc, s_ctx, sk], axis=-1), axis=-1)
    p_loc = p[..., :3 * BLK].astype(v.dtype)
    p_ctx = p[..., 3 * BLK:-1].astype(v.dtype)
    o = (jnp.einsum('bnkgqj,bnjkd->bnqkgd', p_loc, vw)
         + jnp.einsum('bnkgqj,bjkd->bnqkgd', p_ctx, vc))
    return o.reshape(b, s_len, kvh * g * d)


def fourier_mix(u, w_f):
    b, s, _ = u.shape
    ug = u.reshape(b, s, C_GROUPS, C_GROUP_DIM).astype(jnp.float32)
    f = jnp.fft.fft2(ug, axes=(1, 3), norm="ortho").real.astype(u.dtype)
    return jnp.einsum('bsgc,gcd->bsgd', f, w_f).reshape(b, s, C_WIDTH)


def mixer_layer(x, shift, scale, gate, norm_g, w_in, lam, lam_init, diff_g, sink, w_f, w_out,
                rope_a=None, rope_b=None, ctx=None):
    b, s, _ = x.shape
    h = rms_norm(x, norm_g) * (1.0 + scale) + shift
    proj = h @ w_in
    qa, ka, va, qbq, kbk, vbv, uc, z = jnp.split(proj, split_points(), axis=-1)
    qa = qa.reshape(b, s, A_HEADS, 2, A_QK_DIM)
    ka = ka.reshape(b, s, A_HEADS, 2, A_QK_DIM)
    va = va.reshape(b, s, A_HEADS, A_V_DIM)
    qbq = qbq.reshape(b, s, B_KV_HEADS, B_GROUP, B_HEAD_DIM)
    kbk = kbk.reshape(b, s, B_KV_HEADS, B_HEAD_DIM)
    vbv = vbv.reshape(b, s, B_KV_HEADS, B_HEAD_DIM)
    if ctx is None:
        oa = diff_attention(qa, ka, va, lam)
        ob = sink_attention(qbq, kbk, vbv, sink)
        new_ctx = (ka.reshape(b, s, A_HEADS, 2 * A_QK_DIM), va, kbk, vbv)
    else:
        cos_a, sin_a = rope_a
        cos_b, sin_b = rope_b
        kc_a, vc_a, kc_b, vc_b = ctx
        n_ctx = kc_a.shape[1]
        k_all = jnp.concatenate([apply_rope(ka, cos_a, sin_a),
                                 kc_a.reshape(b, n_ctx, A_HEADS, 2, A_QK_DIM)], axis=1)
        v_all = jnp.concatenate([va, vc_a], axis=1)
        oa = diff_attention(apply_rope(qa, cos_a, sin_a), k_all, v_all, lam)
        ob = banded_sink_attention(apply_rope(qbq, cos_b, sin_b), apply_rope(kbk, cos_b, sin_b),
                                   vbv, kc_b, vc_b, sink)
        new_ctx = None
    oa = (rms_norm(oa, diff_g) * (1.0 - lam_init)).reshape(b, s, A_WIDTH)
    oc = fourier_mix(uc, w_f)
    mix = jnp.concatenate([oa, ob, oc], axis=-1) * jax.nn.silu(z)
    return x + gate * (mix @ w_out), new_ctx


def setup_inputs(seed: int = 0) -> dict:
    key = jax.random.key(seed)
    ks = jax.random.split(key, 24)
    f32 = jnp.float32
    n = lambda k, shp: jax.random.normal(k, shp, dtype=f32)
    return {
        "x_prompt": n(ks[0], (BATCH, SEQ, D_MODEL)),
        "x_sample": n(ks[1], (DEC_BATCH, DEC_SEQ, D_MODEL)),
        "cache_diff_k": n(ks[2], (DEC_BATCH, DEPTH, PAST_LEN, A_HEADS, 2 * A_QK_DIM)),
        "cache_diff_v": n(ks[3], (DEC_BATCH, DEPTH, PAST_LEN, A_HEADS, A_V_DIM)),
        "cache_swa_k": n(ks[4], (DEC_BATCH, DEPTH, PAST_LEN, B_KV_HEADS, B_HEAD_DIM)),
        "cache_swa_v": n(ks[5], (DEC_BATCH, DEPTH, PAST_LEN, B_KV_HEADS, B_HEAD_DIM)),
        "c": n(ks[6], (DEC_BATCH, D_MODEL)),
        "c_ctx": n(ks[7], (D_MODEL,)),
        "w_ada": n(ks[8], (DEPTH, D_MODEL, 3 * D_MODEL)) * D_MODEL ** -0.5,
        "b_ada": n(ks[9], (DEPTH, 3 * D_MODEL)) * 0.01,
        "norm_g": 1.0 + 0.1 * n(ks[10], (DEPTH, D_MODEL)),
        "w_in": n(ks[11], (DEPTH, D_MODEL, IN_COLS)) * D_MODEL ** -0.5,
        "lam_q1": n(ks[12], (DEPTH, A_QK_DIM)) * 0.1,
        "lam_k1": n(ks[13], (DEPTH, A_QK_DIM)) * 0.1,
        "lam_q2": n(ks[14], (DEPTH, A_QK_DIM)) * 0.1,
        "lam_k2": n(ks[15], (DEPTH, A_QK_DIM)) * 0.1,
        "diff_norm_g": 1.0 + 0.1 * n(ks[16], (DEPTH, A_V_DIM)),
        "sink": n(ks[17], (DEPTH, B_KV_HEADS, B_GROUP)) * 0.5,
        "w_fourier": n(ks[18], (DEPTH, C_GROUPS, C_GROUP_DIM, C_GROUP_DIM)) * C_GROUP_DIM ** -0.5,
        "w_out": n(ks[19], (DEPTH, D_MIX, D_MODEL)) * D_MIX ** -0.5,
        "final_g": 1.0 + 0.1 * n(ks[20], (D_MODEL,)),
    }


def reference(x_prompt, x_sample, cache_diff_k, cache_diff_v, cache_swa_k, cache_swa_v, c, c_ctx,
              w_ada, b_ada, norm_g, w_in, lam_q1, lam_k1, lam_q2, lam_k2, diff_norm_g, sink,
              w_fourier, w_out, final_g):
    n_lat = x_sample.shape[1]
    rope_a = axial_rope_tables(n_lat, A_QK_DIM, x_sample.dtype)
    rope_b = axial_rope_tables(n_lat, B_HEAD_DIM, x_sample.dtype)
    xc = x_prompt
    xs = x_sample
    new_dk, new_dv, new_sk, new_sv = [], [], [], []
    for l in range(DEPTH):
        lam_init = 0.8 - 0.6 * math.exp(-0.3 * l)
        lam = (jnp.exp(jnp.sum(lam_q1[l].astype(jnp.float32) * lam_k1[l].astype(jnp.float32)))
               - jnp.exp(jnp.sum(lam_q2[l].astype(jnp.float32) * lam_k2[l].astype(jnp.float32)))
               + lam_init)
        mod_c = jax.nn.silu(c_ctx) @ w_ada[l] + b_ada[l]
        sh_c, sc_c, g_c = jnp.split(mod_c, 3, axis=-1)
        xc, (dk, dv, sk, sv) = mixer_layer(xc, sh_c, sc_c, g_c, norm_g[l], w_in[l], lam, lam_init,
                                           diff_norm_g[l], sink[l], w_fourier[l], w_out[l])
        new_dk.append(dk)
        new_dv.append(dv)
        new_sk.append(sk)
        new_sv.append(sv)
        mod_s = (jax.nn.silu(c) @ w_ada[l] + b_ada[l])[:, None, :]
        sh_s, sc_s, g_s = jnp.split(mod_s, 3, axis=-1)
        ctx = (cache_diff_k[:, l], cache_diff_v[:, l], cache_swa_k[:, l], cache_swa_v[:, l])
        xs, _ = mixer_layer(xs, sh_s, sc_s, g_s, norm_g[l], w_in[l], lam, lam_init,
                            diff_norm_g[l], sink[l], w_fourier[l], w_out[l],
                            rope_a=rope_a, rope_b=rope_b, ctx=ctx)
    y_prompt = rms_norm(xc, final_g)
    y_sample = rms_norm(xs, final_g)
    new_diff_k = jnp.stack(new_dk, axis=1)
    new_diff_v = jnp.stack(new_dv, axis=1)
    new_swa_k = jnp.stack(new_sk, axis=1)
    new_swa_v = jnp.stack(new_sv, axis=1)
    return (y_prompt, y_sample, new_diff_k, new_diff_v, new_swa_k, new_swa_v)
```

```cpp
#include <hip/hip_runtime.h>
#include <cstdio>
#include <cstdint>
#include <cmath>
constexpr int DM = 1024, NCTX = 8192, NLAT = 16384, MTOK = NCTX + NLAT, DEPTH = 4, LDP = 3584, NIN = 3328;
constexpr int C_QA = 0, C_KA = 512, C_VA = 1024, C_QB = 1536, C_KB = 1792, C_VB = 1920, C_VF = 2048, C_Z = 2560;
constexpr int NWAVES = 8;
constexpr float RMS_EPS = 1e-6f;
constexpr size_t MiB = 1u << 20;
constexpr size_t WS_CTL = 0, CTL_ZERO_BYTES = 1 * MiB;
constexpr size_t WS_MOD = 1 * MiB;
constexpr size_t WS_G = WS_MOD + MiB / 2;
constexpr size_t WS_ROPE = 2 * MiB;
constexpr size_t WS_DFTC = 2 * MiB + MiB / 4;
constexpr size_t WS_DFTL = 3 * MiB;
constexpr size_t WS_WIN = 19 * MiB;
constexpr size_t WS_WOUT = 26 * MiB;
constexpr size_t WS_CKA = 28 * MiB, WS_CVA = 30 * MiB, WS_CKB = 32 * MiB, WS_CVB = WS_CKB + MiB / 2;
constexpr size_t WS_ACT = 33 * MiB;
constexpr size_t WS_PROJ = 81 * MiB;
constexpr size_t WS_END = 249 * MiB;
static_assert(WS_PROJ + (size_t)MTOK * LDP * 2 <= WS_END && WS_ACT + (size_t)MTOK * DM * 2 <= WS_PROJ, "ws map");
constexpr int CW_BAR = 4096;
constexpr int RING_OFF = 0, RING_BYTES = 131072;
constexpr int LDSCTL_OFF = RING_BYTES, MISC_OFF = LDSCTL_OFF + 320;
constexpr int LDS_BYTES = 147456;

typedef const float* cfp_t;
typedef __attribute__((address_space(4))) const char* kaptr_t;
typedef __attribute__((address_space(4))) const cfp_t* kcfp_t;
__device__ __forceinline__ const float* in_ptr(int i) {
    kaptr_t ka = (kaptr_t)__builtin_amdgcn_kernarg_segment_ptr();
    asm volatile("" : "+s"(ka));
    return *(kcfp_t)(ka + 8 * i);
}
namespace pg8 {
#define PG8_LAS __attribute__((address_space(3)))
typedef unsigned short bf16_t;
typedef short bf16x8 __attribute__((ext_vector_type(8)));
typedef float f32x4 __attribute__((ext_vector_type(4)));
typedef unsigned u32x4 __attribute__((ext_vector_type(4)));
constexpr int BM = 256, BK = 64, HALF = 128, HTB = HALF * BK * 2  , STAGE_BYTES = 8 * HTB, NXCD = 8, WGM = 8;

__host__ __device__ __forceinline__ int lds_byte(int r, int c) { const int st = (r >> 4) * 2 + (c >> 5), rr = r & 15, cc = c & 31, ob = rr * 64 + cc * 2; return st * 1024 + (ob ^ (((ob >> 9) & 1) << 5)); }
__host__ __device__ __forceinline__ void stage_rc(int b, int& R, int& C) { const int st = b / 1024, sb = b % 1024, swz = sb ^ (((sb >> 9) & 1) << 5); R = (st >> 1) * 16 + swz / 64; C = (st & 1) * 32 + (swz % 64) / 2; }
__host__ __device__ __forceinline__ int perm32(int rho) { const int n = rho >> 4, i = rho & 15; return 8 * (i >> 2) + 4 * n + (i & 3); }

struct Unit { int pm, pn; };
struct Gemm { const bf16_t* A; const bf16_t* Bt; int M, N, K; };

struct StaticOrder {
    int nM, nN, nwg, G, c;
    __host__ __device__ void init(int M, int N, int G_, int c_) { nM = M / BM; nN = N / BM; nwg = nM * nN; G = G_; c = c_; }
    __host__ __device__ bool next(int i, Unit& u) const {
        const long L = (long)i * G + c; if (L >= nwg) return false;
        int wgid = (int)L; { const int q = nwg / NXCD, r = nwg % NXCD, xcd = wgid % NXCD, off = wgid / NXCD; wgid = (xcd < r ? xcd * (q + 1) : r * (q + 1) + (xcd - r) * q) + off; }
        const int nig = WGM * nN, gid = wgid / nig, fm = gid * WGM, gsz = (nM - fm) < WGM ? (nM - fm) : WGM;
        u.pm = fm + ((wgid % nig) % gsz); u.pn = (wgid % nig) / gsz; return true;
    }
    __device__ __forceinline__ void a_ready(const Unit&) const {}
    __device__ __forceinline__ void done(const Unit&) const {}
};

__device__ __forceinline__ unsigned cvt_pk_bf16(float lo, float hi) { unsigned r; asm volatile("v_cvt_pk_bf16_f32 %0, %1, %2" : "=v"(r) : "v"(lo), "v"(hi)); return r; }
struct EpiInProj {
    static constexpr bool PERM = true, AFTER_DRAIN = false;
    unsigned char* ws; float* out; int layer;
    __device__ __forceinline__ void operator()(const f32x4 (&acc)[2][2][4][2], const Unit& u, int wr, int wc, int fr, int fq) const {
        const bool ctx = u.pm < 32;
        bf16_t* P = (bf16_t*)(ws + WS_PROJ); const float* rcos = (const float*)(ws + WS_ROPE); const float* rsin = rcos + 1024;
        float* o_dk = out + (size_t)MTOK * DM; float* o_dv = o_dk + 32L * 4 * 256 * 512; float* o_sk = o_dv + 32L * 4 * 256 * 512; float* o_sv = o_sk + 32L * 4 * 256 * 128;
#pragma unroll
        for (int bj = 0; bj < 2; ++bj) {
            const int colb = u.pn * 256 + bj * 128;
            const int col0 = colb + wc * 32 + 8 * fq;
            const bool rope = !ctx && (colb < 1024 || (colb >= 1536 && colb < 1920));
            const bool silu = colb >= 2560;
            float* fo = nullptr; int fld = 0, fcol = 0;
            if (ctx) {
                if (colb >= 512 && colb < 1024) { fo = o_dk; fld = 512; fcol = col0 - 512; }
                else if (colb >= 1024 && colb < 1536) { fo = o_dv; fld = 512; fcol = col0 - 1024; }
                else if (colb == 1792) { fo = o_sk; fld = 128; fcol = col0 - 1792; }
                else if (colb == 1920) { fo = o_sv; fld = 128; fcol = col0 - 1920; }
            }
            const float sgn = (fq < 2) ? -1.f : 1.f;
            const int ti = 8 * (fq & 1);
#pragma unroll
            for (int ai = 0; ai < 2; ++ai)
#pragma unroll
                for (int m = 0; m < 4; ++m) {
                    const int row = u.pm * 256 + ai * 128 + wr * 64 + m * 16 + fr;
                    f32x4 v0 = acc[ai][bj][m][0], v1 = acc[ai][bj][m][1];
                    if (rope) {
                        const int s = (row - NCTX) & 2047; const int pos = (wc & 1) ? (s & 63) : (s >> 6);
                        const f32x4 c0 = *(const f32x4*)(rcos + pos * 16 + ti), c1 = *(const f32x4*)(rcos + pos * 16 + ti + 4);
                        const f32x4 s0 = *(const f32x4*)(rsin + pos * 16 + ti), s1 = *(const f32x4*)(rsin + pos * 16 + ti + 4);
                        f32x4 p0, p1;
#pragma unroll
                        for (int e = 0; e < 4; ++e) { p0[e] = __shfl_xor(v0[e], 32); p1[e] = __shfl_xor(v1[e], 32); }
                        v0 = v0 * c0 + (p0 * s0) * sgn; v1 = v1 * c1 + (p1 * s1) * sgn;
                    }
                    if (silu) {
#pragma unroll
                        for (int e = 0; e < 4; ++e) { v0[e] = v0[e] / (1.f + __expf(-v0[e])); v1[e] = v1[e] / (1.f + __expf(-v1[e])); }
                    }
                    u32x4 w; w.x = cvt_pk_bf16(v0[0], v0[1]); w.y = cvt_pk_bf16(v0[2], v0[3]); w.z = cvt_pk_bf16(v1[0], v1[1]); w.w = cvt_pk_bf16(v1[2], v1[3]);
                    *(u32x4*)(P + (size_t)row * LDP + col0) = w;
                    if (fo) { const int b = row >> 8, s = row & 255; float* dst = fo + (size_t)((b * 4 + layer) * 256 + s) * fld + fcol; *(f32x4*)dst = v0; *(f32x4*)(dst + 4) = v1; }
                    asm volatile("" ::: "memory");
                }
        }
    }
};
struct EpiOutProj {
    static constexpr bool PERM = false, AFTER_DRAIN = false;
    unsigned char* ws; float* out; int layer;
    __device__ __forceinline__ void operator()(const f32x4 (&acc)[2][2][4][2], const Unit& u, int wr, int wc, int fr, int fq) const {
        float* X = out; const float* mod = (const float*)(ws + WS_MOD) + (size_t)layer * 9 * 3072;
        const float* xin_c = layer == 0 ? in_ptr(0) : X; const float* xin_l = layer == 0 ? in_ptr(1) : X + (size_t)NCTX * DM;
        const bool ctx = u.pm < 32; const int p = ctx ? 0 : 1 + ((u.pm - 32) >> 3);
        const float* gate = mod + p * 3072 + 2048;
        const int row0 = u.pm * 256 + wr * 64 + fr, col0 = u.pn * 256 + wc * 32 + 4 * fq;
        f32x4 gv[2][2];
#pragma unroll
        for (int bj = 0; bj < 2; ++bj)
#pragma unroll
            for (int n = 0; n < 2; ++n) gv[bj][n] = *(const f32x4*)(gate + col0 + bj * 128 + n * 16);
#pragma unroll
        for (int ai = 0; ai < 2; ++ai)
#pragma unroll
            for (int m = 0; m < 4; ++m) {
                const int row = row0 + ai * 128 + m * 16;
                const float* src = ctx ? xin_c + (size_t)row * 1024 : xin_l + (size_t)(row - NCTX) * 1024;
                float* dst = X + (size_t)row * 1024;
#pragma unroll
                for (int bj = 0; bj < 2; ++bj)
#pragma unroll
                    for (int n = 0; n < 2; ++n) { const int c = col0 + bj * 128 + n * 16; const f32x4 xo = *(const f32x4*)(src + c); *(f32x4*)(dst + c) = xo + gv[bj][n] * acc[ai][bj][m][n]; }
                if (m & 1) asm volatile("" ::: "memory");
            }
    }
};
template <class Epi, class Sched, bool ALIGN_EPI = false, bool SP2 = false>
__device__ __forceinline__ void gemm_phase(PG8_LAS unsigned char* lds, const Gemm g, const Sched& S, const Epi& E) {
    int tid_ = threadIdx.x; asm volatile("" : "+v"(tid_));
    const int tid = tid_, wid = __builtin_amdgcn_readfirstlane(tid >> 6), lane = tid & 63, wr = wid >> 2, wc = wid & 3, fr = lane & 15, fq = lane >> 4;
    const int K = g.K, nt = K / BK;
    unsigned voffA[2], voffB[2];
#pragma unroll
    for (int i = 0; i < 2; ++i) { int R, C; stage_rc(tid * 16 + i * 8192, R, C); const int Rb = Epi::PERM ? ((R & ~31) + perm32(R & 31)) : R;
        voffA[i] = (unsigned)(R * K + C) * 2u; voffB[i] = (unsigned)(Rb * K + C) * 2u; }
    const size_t kstep = (size_t)(BK * 2);
    const size_t hstep = (size_t)HALF * K * 2;
    const size_t tstep = 2 * hstep;
    const unsigned ldsw = (unsigned)wid * 1024u;
    const int aoff = lds_byte(wr * 64 + fr, fq * 8), boff = lds_byte(wc * 32 + fr, fq * 8);
#define PG8_SA(b, h) (((b) * 2 + (h)) * HTB)
#define PG8_SB(b, h) ((4 + (b) * 2 + (h)) * HTB)
#define PG8_STAGE(bufoff, gbase, voff) do { _Pragma("unroll") for (int _i = 0; _i < 2; ++_i) \
        __builtin_amdgcn_global_load_lds((const unsigned*)((const char*)(gbase) + (voff)[_i]), (PG8_LAS unsigned*)(lds + (bufoff) + ldsw + _i * 8192), 16, 0, 0); } while (0)
#define PG8_LDA(dst, b, h) do { _Pragma("unroll") for (int m = 0; m < 4; ++m) _Pragma("unroll") for (int k = 0; k < 2; ++k) dst[m][k] = *(const PG8_LAS bf16x8*)(lds + PG8_SA(b, h) + aoff + m * 2048 + k * 1024); } while (0)
#define PG8_LDB(dst, b, h) do { _Pragma("unroll") for (int n = 0; n < 2; ++n) _Pragma("unroll") for (int k = 0; k < 2; ++k) dst[n][k] = *(const PG8_LAS bf16x8*)(lds + PG8_SB(b, h) + boff + n * 2048 + k * 1024); } while (0)
#define PG8_MMA(ai, bj, At, Bt) do { __builtin_amdgcn_s_setprio(1); _Pragma("unroll") for (int m = 0; m < 4; ++m) _Pragma("unroll") for (int n = 0; n < 2; ++n) _Pragma("unroll") for (int k = 0; k < 2; ++k) \
        acc[ai][bj][m][n] = __builtin_amdgcn_mfma_f32_16x16x32_bf16(Bt[n][k], At[m][k], acc[ai][bj][m][n], 0, 0, 0); __builtin_amdgcn_s_setprio(0); } while (0)
#define PG8_WAIT_V(n) asm volatile("s_waitcnt vmcnt(" #n ")" ::: "memory")
#define PG8_WAIT_L(n) asm volatile("s_waitcnt lgkmcnt(" #n ")" ::: "memory")
#define PG8_BAR __builtin_amdgcn_s_barrier()
#define PG8_SCHED __builtin_amdgcn_sched_barrier(0)
    Unit cur, nxt; int ui = 0;
    if (!S.next(0, cur)) return;
    f32x4 acc[2][2][4][2];
#pragma unroll
    for (int a = 0; a < 2; ++a)
#pragma unroll
        for (int b = 0; b < 2; ++b)
#pragma unroll
            for (int m = 0; m < 4; ++m)
#pragma unroll
                for (int n = 0; n < 2; ++n) acc[a][b][m][n] = (f32x4){0.f, 0.f, 0.f, 0.f};
    bf16x8 At[4][2], B0[2][2], B1[2][2];
    const char* cA = (const char*)g.A + (size_t)cur.pm * tstep; const char* cB = (const char*)g.Bt + (size_t)cur.pn * tstep;
    S.a_ready(cur);
    if constexpr (SP2) {
        PG8_STAGE(PG8_SB(0, 0), cB, voffB); PG8_STAGE(PG8_SB(0, 1), cB + hstep, voffB); PG8_STAGE(PG8_SA(0, 0), cA, voffA); PG8_STAGE(PG8_SA(0, 1), cA + hstep, voffA);
        if (wr == 1) PG8_BAR;
        PG8_WAIT_V(2); PG8_BAR;
        PG8_STAGE(PG8_SB(1, 0), cB + kstep, voffB); PG8_STAGE(PG8_SA(1, 0), cA + kstep, voffA); PG8_STAGE(PG8_SB(1, 1), cB + hstep + kstep, voffB);
        PG8_WAIT_V(6); PG8_BAR;
    } else {
        PG8_STAGE(PG8_SB(0, 0), cB, voffB); PG8_STAGE(PG8_SA(0, 0), cA, voffA); PG8_STAGE(PG8_SB(0, 1), cB + hstep, voffB); PG8_STAGE(PG8_SA(0, 1), cA + hstep, voffA);
        if (wr == 1) PG8_BAR;
        PG8_WAIT_V(4); PG8_BAR;
        PG8_STAGE(PG8_SB(1, 0), cB + kstep, voffB); PG8_STAGE(PG8_SA(1, 0), cA + kstep, voffA); PG8_STAGE(PG8_SB(1, 1), cB + hstep + kstep, voffB);
        PG8_WAIT_V(6); PG8_BAR;
    }
    for (;;) {
        const bool has_next = S.next(ui + 1, nxt);
        const char* nA = has_next ? (const char*)g.A + (size_t)nxt.pm * tstep : cA; const char* nB = has_next ? (const char*)g.Bt + (size_t)nxt.pn * tstep : cB;
        for (int t = 0; t < nt; t += 2) {
            const bool last = (t == nt - 2);
            const char* a1 = cA + (size_t)(t + 1) * kstep;
            const char* a2 = last ? nA : cA + (size_t)(t + 2) * kstep; const char* b2 = last ? nB : cB + (size_t)(t + 2) * kstep;
            const char* a3 = a2 + kstep; const char* b3 = b2 + kstep;
            if (last && has_next) S.a_ready(nxt);
            if constexpr (SP2) {
            PG8_LDB(B0, 0, 0); PG8_LDB(B1, 0, 1); PG8_SCHED; PG8_LDA(At, 0, 0); PG8_STAGE(PG8_SA(1, 1), a1 + hstep, voffA);
            PG8_WAIT_V(8); PG8_WAIT_L(0); PG8_BAR; PG8_MMA(0, 0, At, B0); PG8_MMA(0, 1, At, B1); PG8_BAR; PG8_SCHED;
            PG8_LDA(At, 0, 1); PG8_STAGE(PG8_SB(0, 0), b2, voffB); PG8_STAGE(PG8_SB(0, 1), b2 + hstep, voffB); PG8_STAGE(PG8_SA(0, 0), a2, voffA);
            PG8_WAIT_V(8); PG8_WAIT_L(0); PG8_BAR; PG8_MMA(1, 0, At, B0); PG8_MMA(1, 1, At, B1); PG8_BAR; PG8_SCHED;
            PG8_LDB(B0, 1, 0); PG8_LDB(B1, 1, 1); PG8_SCHED; PG8_LDA(At, 1, 0); PG8_STAGE(PG8_SA(0, 1), a2 + hstep, voffA);
            PG8_WAIT_V(8); PG8_WAIT_L(0); PG8_BAR; PG8_MMA(0, 0, At, B0); PG8_MMA(0, 1, At, B1); PG8_BAR; PG8_SCHED;
            PG8_LDA(At, 1, 1); PG8_STAGE(PG8_SB(1, 0), b3, voffB); PG8_STAGE(PG8_SB(1, 1), b3 + hstep, voffB); PG8_STAGE(PG8_SA(1, 0), a3, voffA);
            PG8_WAIT_V(8); PG8_WAIT_L(0); PG8_BAR; PG8_MMA(1, 0, At, B0); PG8_MMA(1, 1, At, B1); PG8_BAR; PG8_SCHED;
            } else {
            PG8_LDB(B0, 0, 0); PG8_SCHED; PG8_LDA(At, 0, 0); PG8_STAGE(PG8_SA(1, 1), a1 + hstep, voffA);
            PG8_WAIT_L(8); PG8_BAR; PG8_WAIT_L(0); PG8_MMA(0, 0, At, B0); PG8_BAR; PG8_SCHED;
            PG8_LDB(B1, 0, 1); PG8_STAGE(PG8_SB(0, 0), b2, voffB);
            PG8_BAR; PG8_WAIT_L(0); PG8_MMA(0, 1, At, B1); PG8_BAR;
            PG8_LDA(At, 0, 1); PG8_STAGE(PG8_SA(0, 0), a2, voffA);
            PG8_BAR; PG8_WAIT_L(0); PG8_MMA(1, 0, At, B0); PG8_BAR; PG8_SCHED;
            PG8_STAGE(PG8_SB(0, 1), b2 + hstep, voffB);
            PG8_WAIT_V(6); PG8_BAR; PG8_MMA(1, 1, At, B1); PG8_BAR;
            PG8_LDB(B0, 1, 0); PG8_SCHED; PG8_LDA(At, 1, 0); PG8_STAGE(PG8_SA(0, 1), a2 + hstep, voffA);
            PG8_WAIT_L(8); PG8_BAR; PG8_WAIT_L(0); PG8_MMA(0, 0, At, B0); PG8_BAR; PG8_SCHED;
            PG8_LDB(B1, 1, 1); PG8_STAGE(PG8_SB(1, 0), b3, voffB);
            PG8_BAR; PG8_WAIT_L(0); PG8_MMA(0, 1, At, B1); PG8_BAR;
            PG8_LDA(At, 1, 1); PG8_STAGE(PG8_SA(1, 0), a3, voffA);
            PG8_BAR; PG8_WAIT_L(0); PG8_MMA(1, 0, At, B0); PG8_BAR; PG8_SCHED;
            PG8_STAGE(PG8_SB(1, 1), b3 + hstep, voffB);
            PG8_WAIT_V(6); PG8_BAR; PG8_MMA(1, 1, At, B1); PG8_BAR;
            }
        }
        if constexpr (ALIGN_EPI) { if (wr == 0) PG8_BAR; }
        if constexpr (!Epi::AFTER_DRAIN) { E(acc, cur, wr, wc, fr, fq); S.done(cur); }
        if (!has_next) break;
#pragma unroll
        for (int a = 0; a < 2; ++a)
#pragma unroll
            for (int b = 0; b < 2; ++b)
#pragma unroll
                for (int m = 0; m < 4; ++m)
#pragma unroll
                    for (int n = 0; n < 2; ++n) acc[a][b][m][n] = (f32x4){0.f, 0.f, 0.f, 0.f};
        cur = nxt; cA = nA; cB = nB; ++ui;
        if constexpr (ALIGN_EPI) { if (wr == 1) PG8_BAR; }
    }
    PG8_WAIT_V(0);
    if constexpr (!ALIGN_EPI) { if (wr == 0) PG8_BAR; }
    PG8_BAR;
    if constexpr (Epi::AFTER_DRAIN) { E.fused(acc, cur, wr, wc, fr, fq, lds, wid, lane); S.done(cur); }
#undef PG8_SA
#undef PG8_SB
#undef PG8_STAGE
#undef PG8_LDA
#undef PG8_LDB
#undef PG8_MMA
#undef PG8_WAIT_V
#undef PG8_WAIT_L
#undef PG8_BAR
#undef PG8_SCHED
}
}
#define GAS __attribute__((address_space(1)))
#define LAS __attribute__((address_space(3)))
typedef unsigned short bf16;
typedef unsigned v4u __attribute__((ext_vector_type(4)));
typedef float f32x4 __attribute__((ext_vector_type(4)));
typedef short bf16x8 __attribute__((ext_vector_type(8)));
typedef GAS unsigned gu32;
typedef GAS unsigned long long gu64;
#define RLX_AGENT __ATOMIC_RELAXED, __HIP_MEMORY_SCOPE_AGENT
#define LDS_WAIT() asm volatile("s_waitcnt lgkmcnt(0)" ::: "memory")
#define VM_WAIT() asm volatile("s_waitcnt vmcnt(0)" ::: "memory")
__device__ __forceinline__ unsigned long long rt() { return __builtin_amdgcn_s_memrealtime(); }
__device__ __forceinline__ unsigned f2bf(float f) { unsigned u = __builtin_bit_cast(unsigned, f); return (u + 0x7fffu + ((u >> 16) & 1u)) >> 16; }
__device__ __forceinline__ unsigned pk2(float lo, float hi) { return f2bf(lo) | (f2bf(hi) << 16); }

#define XB_TMO      128
#define XB_XCNT(j)  (256  + 64 * (j))
#define XB_XSUB(j)  (1280 + 64 * (j))
#define XB_XGEN(j)  (2304 + 64 * (j))
#define XB_TOP      3328
#define XB_TOPGEN   3392
#define XCD_BAR_WORDS 3456
#define XB_SPIN_CAP (1u << 18)

__device__ __forceinline__ unsigned xb_ld(unsigned* p)              { return __hip_atomic_load(p, __ATOMIC_RELAXED, __HIP_MEMORY_SCOPE_AGENT); }
__device__ __forceinline__ unsigned xb_add(unsigned* p, unsigned v) { return __hip_atomic_fetch_add(p, v, __ATOMIC_RELAXED, __HIP_MEMORY_SCOPE_AGENT); }
__device__ __forceinline__ unsigned xb_xcc_id() { return (unsigned)__builtin_amdgcn_s_getreg((3 << 11) | 20) & 0xFu; }
#define XB_SPIN(cond, bar) do { unsigned _sp = 0; while (cond) { __builtin_amdgcn_s_sleep(1); \
    if ((++_sp & 255u) == 0u) { if (xb_ld(&(bar)[XB_TMO])) break; if (_sp > XB_SPIN_CAP) { atomicAdd(&(bar)[XB_TMO], 1u); break; } } } } while (0)

struct XcdBarrier {
    unsigned* bar; unsigned x;
    volatile LAS unsigned* st;
};

__device__ __forceinline__ XcdBarrier xcd_barrier_post(unsigned* bar, volatile LAS unsigned* st) {
    XcdBarrier b; b.bar = bar; b.x = xb_xcc_id(); b.st = st;
    if (threadIdx.x == 0) (void)xb_add(&bar[XB_XCNT(b.x)], 1u);
    return b;
}
__device__ __forceinline__ void xcd_barrier_complete(unsigned* bar, unsigned x, unsigned& nloc, unsigned& nx) {
    const unsigned G = gridDim.x * gridDim.y * gridDim.z;
    unsigned sum, cnt, mine, sp = 0u;
    for (;;) {
        sum = 0u; cnt = 0u; mine = 0u;
#pragma unroll
        for (unsigned j = 0; j < 16; ++j) { const unsigned c = xb_ld(&bar[XB_XCNT(j)]); sum += c; cnt += (c > 0u) ? 1u : 0u; mine = (j == x) ? c : mine; }
        if (sum == G) break;
        __builtin_amdgcn_s_sleep(1);
        if ((++sp & 255u) == 0u) { if (xb_ld(&bar[XB_TMO])) break; if (sp > XB_SPIN_CAP) { atomicAdd(&bar[XB_TMO], 1u); break; } }
    }
    nloc = mine > 0u ? mine : 1u; nx = cnt > 0u ? cnt : 1u;
}

__device__ __forceinline__ void xcd_barrier(const XcdBarrier& b) {
    asm volatile("s_waitcnt vmcnt(0)" ::: "memory");
    __syncthreads();
    if (threadIdx.x == 0) {
        unsigned* bar = b.bar;
        __builtin_amdgcn_s_waitcnt(0);
        unsigned nloc = b.st[0], nx = b.st[1];
        if (nloc == 0u) { xcd_barrier_complete(bar, b.x, nloc, nx); b.st[0] = nloc; b.st[1] = nx; }
        const unsigned old = xb_add(&bar[XB_XSUB(b.x)], 1u);
        const unsigned gen = old / nloc;
        if (old + 1u == (gen + 1u) * nloc) {
            __builtin_amdgcn_fence(__ATOMIC_RELEASE, "agent");
            asm volatile("s_waitcnt vmcnt(0)" ::: "memory");
            const unsigned og = xb_add(&bar[XB_TOP], 1u);
            const unsigned tg = og / nx;
            if (og + 1u == (tg + 1u) * nx) xb_add(&bar[XB_TOPGEN], 1u);
            else XB_SPIN(xb_ld(&bar[XB_TOPGEN]) == tg, bar);
            __builtin_amdgcn_fence(__ATOMIC_ACQUIRE, "agent");
            xb_add(&bar[XB_XGEN(b.x)], 1u);
            asm volatile("s_waitcnt vmcnt(0)" ::: "memory");
        } else {
            XB_SPIN(xb_ld(&bar[XB_XGEN(b.x)]) == gen, bar);
            __builtin_amdgcn_fence(__ATOMIC_ACQUIRE, "agent");
            asm volatile("s_waitcnt vmcnt(0)" ::: "memory");
        }
    }
    __syncthreads();
}

struct Frame {
    LAS unsigned char* lds;
    int tid, lane, wave, G;
    float* out;
    unsigned char* ws;
    __device__ __forceinline__ float* MOD() const { return (float*)(ws + WS_MOD); }
    __device__ __forceinline__ float* GF() const { return (float*)(ws + WS_G); }
    __device__ __forceinline__ float* ROPE() const { return (float*)(ws + WS_ROPE); }
    __device__ __forceinline__ bf16* DFTC() const { return (bf16*)(ws + WS_DFTC); }
    __device__ __forceinline__ bf16* DFTL() const { return (bf16*)(ws + WS_DFTL); }
    __device__ __forceinline__ bf16* WIN() const { return (bf16*)(ws + WS_WIN); }
    __device__ __forceinline__ bf16* WOUT() const { return (bf16*)(ws + WS_WOUT); }
    __device__ __forceinline__ bf16* CKA() const { return (bf16*)(ws + WS_CKA); }
    __device__ __forceinline__ bf16* CVA() const { return (bf16*)(ws + WS_CVA); }
    __device__ __forceinline__ bf16* CKB() const { return (bf16*)(ws + WS_CKB); }
    __device__ __forceinline__ bf16* CVB() const { return (bf16*)(ws + WS_CVB); }
    __device__ __forceinline__ bf16* ACT() const { return (bf16*)(ws + WS_ACT); }
    __device__ __forceinline__ bf16* PROJ() const { return (bf16*)(ws + WS_PROJ); }
};
__device__ __forceinline__ float wave_sum(float v) {
#pragma unroll
    for (int o = 1; o < 64; o <<= 1) v += __shfl_xor(v, o);
    return v;
}
__device__ __forceinline__ float bf2f(unsigned short h) { return __builtin_bit_cast(float, (unsigned)h << 16); }
__device__ __forceinline__ float silu_f(float v) { return v / (1.f + __expf(-v)); }

__device__ __forceinline__ void p0_transpose_item(const float* W, int K, int N, bf16* WT, int row_off, LAS float* scr, int item, int lane) {
    const int nblk = N / 32, kb = item / nblk, nb = item % nblk, k0 = 64 * kb, n0 = 32 * nb;
#pragma unroll 8
    for (int i = 0; i < 32; ++i) { const int kk = 2 * i + (lane >> 5); scr[kk * 33 + (lane & 31)] = W[(size_t)(k0 + kk) * N + n0 + (lane & 31)]; }
    LDS_WAIT(); asm volatile("" ::: "memory");
    const int c = lane & 7;
#pragma unroll
    for (int j = 0; j < 4; ++j) { const int n = (lane >> 3) + 8 * j; const LAS float* s = scr + (8 * c) * 33 + n;
        v4u o; o.x = pk2(s[0 * 33], s[1 * 33]); o.y = pk2(s[2 * 33], s[3 * 33]); o.z = pk2(s[4 * 33], s[5 * 33]); o.w = pk2(s[6 * 33], s[7 * 33]);
        *(GAS v4u*)(WT + (size_t)(row_off + n0 + n) * K + k0 + 8 * c) = o; }
    LDS_WAIT(); asm volatile("" ::: "memory");
}
__device__ __forceinline__ void fold_item(const float* win_l, const float* G_l, bf16* WinT, int item, int lane) {
    const int kb = item >> 4, g = (item >> 2) & 3, nb = item & 3;
    const int k = kb * 64 + lane;
    const float* src = win_l + (size_t)k * NIN + 2048 + g * 64;
    const float* Gg = G_l + g * 64 * 128 + nb * 32;
    float a[32];
#pragma unroll
    for (int nn = 0; nn < 32; ++nn) a[nn] = 0.f;
#pragma unroll 2
    for (int c = 0; c < 64; ++c) { const float wv = src[c];
#pragma unroll
        for (int nn = 0; nn < 32; ++nn) a[nn] += wv * Gg[c * 128 + nn]; }
#pragma unroll
    for (int nn = 0; nn < 32; ++nn) { const int n2 = nb * 32 + nn; const int ri = n2 >> 6, d = n2 & 63; const int nrow = 2048 + ri * 256 + g * 64 + d;
        WinT[(size_t)nrow * 1024 + k] = (bf16)f2bf(a[nn]); }
}
template <bool FINAL>
__device__ __forceinline__ void norm_row(const float* xrow, bf16* orow, float* yrow, const float* g, const float* scale, const float* shift, int lane) {
    const GAS f32x4* xr = (const GAS f32x4*)xrow + lane;
    f32x4 v[4]; float s = 0.f;
#pragma unroll
    for (int j = 0; j < 4; ++j) { v[j] = xr[64 * j]; s += (v[j].x * v[j].x + v[j].y * v[j].y) + (v[j].z * v[j].z + v[j].w * v[j].w); }
    const float rstd = 1.f / sqrtf(wave_sum(s) * (1.f / DM) + RMS_EPS);
#pragma unroll
    for (int j = 0; j < 4; ++j) {
        const int k = 4 * (lane + 64 * j);
        const f32x4 gg = *(const f32x4*)(g + k);
        if (FINAL) { *(f32x4*)(yrow + k) = v[j] * rstd * gg; }
        else {
            const f32x4 sc = *(const f32x4*)(scale + k), sh = *(const f32x4*)(shift + k);
            const f32x4 h = (v[j] * rstd) * (gg * (sc + 1.f)) + sh;
            *(GAS unsigned long long*)(orow + k) = (unsigned long long)pk2(h.x, h.y) | ((unsigned long long)pk2(h.z, h.w) << 32);
        }
    }
}

namespace att {
using bf16x8 = __attribute__((ext_vector_type(8))) short;
using s16x4 = __attribute__((ext_vector_type(4))) short;
using f32x16 = __attribute__((ext_vector_type(16))) float;
using u32x4 = __attribute__((ext_vector_type(4))) unsigned;
constexpr int QBLK = 32, KVBLK = 64;
constexpr float SCALE = 0.125f;
constexpr float THR = 8.f;
constexpr int SHM_V = 64 * 128 * 2, SHM_K = 64 * 128 * 2;
constexpr int LDS_WS = 2 * SHM_V + 2 * SHM_K;
#define KSWZ(row, colB) ((row) * 256 + ((colB) ^ (((row) & 7) << 4)))
#define SBAR() __builtin_amdgcn_sched_barrier(0)
__device__ __forceinline__ int crow(int r, int hi) { return (r & 3) + 8 * (r >> 2) + 4 * hi; }
__device__ __forceinline__ unsigned cvtpk(float lo, float hi) { unsigned r; asm volatile("v_cvt_pk_bf16_f32 %0, %1, %2" : "=v"(r) : "v"(lo), "v"(hi)); return r; }
__device__ __forceinline__ bf16x8 ld8(const bf16* p) { return *reinterpret_cast<const bf16x8*>(p); }

__device__ __forceinline__ void partialSM(f32x16& p0, f32x16& p1, float& m_reg, float& mn, float& alpha) {
  constexpr float C = SCALE * 1.4426950408889634f;
  float pmax = p0[0];
#pragma unroll
  for (int r = 1; r < 16; ++r) pmax = fmaxf(pmax, p0[r]);
#pragma unroll
  for (int r = 0; r < 16; ++r) pmax = fmaxf(pmax, p1[r]);
  { auto rr = __builtin_amdgcn_permlane32_swap(__float_as_uint(pmax), __float_as_uint(pmax), false, false);
    pmax = fmaxf(__uint_as_float(rr[0]), __uint_as_float(rr[1])); }
  if (__builtin_expect(__all(pmax - m_reg <= THR / SCALE), 1)) { mn = m_reg; alpha = 1.f; }
  else { mn = fmaxf(m_reg, pmax); alpha = __builtin_amdgcn_exp2f((m_reg - mn) * C); m_reg = mn; }
  float mnC = -mn * C;
#pragma unroll
  for (int r = 0; r < 16; ++r) p0[r] = fmaf(p0[r], C, mnC);
#pragma unroll
  for (int r = 0; r < 16; ++r) p1[r] = fmaf(p1[r], C, mnC);
#pragma unroll
  for (int r = 0; r < 16; ++r) p0[r] = __builtin_amdgcn_exp2f(p0[r]);
}
__device__ __forceinline__ void finishSM(f32x16& p0, f32x16& p1, float alpha, float& l_reg, bf16x8& pa0, bf16x8& pa1, bf16x8& pa2, bf16x8& pa3) {
#pragma unroll
  for (int r = 0; r < 16; ++r) p1[r] = __builtin_amdgcn_exp2f(p1[r]);
  float ps = 0;
#pragma unroll
  for (int r = 0; r < 16; ++r) ps += p0[r];
#pragma unroll
  for (int r = 0; r < 16; ++r) ps += p1[r];
  { auto rr = __builtin_amdgcn_permlane32_swap(__float_as_uint(ps), __float_as_uint(ps), false, false);
    ps = __uint_as_float(rr[0]) + __uint_as_float(rr[1]); }
  l_reg = l_reg * alpha + ps;
#define PK4(P, BASE, OUT) do { unsigned a0 = cvtpk(P[BASE + 0], P[BASE + 1]), a1 = cvtpk(P[BASE + 2], P[BASE + 3]);   \
    unsigned b0 = cvtpk(P[BASE + 4], P[BASE + 5]), b1 = cvtpk(P[BASE + 6], P[BASE + 7]);                              \
    auto r0 = __builtin_amdgcn_permlane32_swap(a0, b0, false, false); auto r1 = __builtin_amdgcn_permlane32_swap(a1, b1, false, false); \
    u32x4 w = {r0[0], r1[0], r0[1], r1[1]}; OUT = *reinterpret_cast<bf16x8*>(&w); } while (0)
  PK4(p0, 0, pa0); PK4(p0, 8, pa1); PK4(p1, 0, pa2); PK4(p1, 8, pa3);
#undef PK4
}
__device__ __forceinline__ void qkt(f32x16& p0, f32x16& p1, const char* Ks, const bf16x8* qr, int r32, int hi, int kcb) {
  p0 = f32x16{}; p1 = f32x16{};
#pragma unroll
  for (int d0 = 0; d0 < 4; ++d0) { int cb = kcb + (d0 * 16 + hi * 8) * 2;
    bf16x8 b0 = *reinterpret_cast<const bf16x8*>(Ks + KSWZ(r32, cb));
    bf16x8 b1 = *reinterpret_cast<const bf16x8*>(Ks + KSWZ(32 + r32, cb));
    p0 = __builtin_amdgcn_mfma_f32_32x32x16_bf16(b0, qr[d0], p0, 0, 0, 0);
    p1 = __builtin_amdgcn_mfma_f32_32x32x16_bf16(b1, qr[d0], p1, 0, 0, 0); }
}
__device__ __forceinline__ int v_st(int k, int c) { const int kk = (k & ~0xC) | ((k & 4) << 1) | ((k & 8) >> 1); return ((kk >> 3) * 4 + (c >> 5)) * 512 + ((kk & 7) * 32 + (c & 31)) * 2; }
__device__ __forceinline__ int v_rd_base(int lane) { return ((lane & 3) << 3) | (((lane >> 2) & 3) << 6) | (((lane >> 4) & 1) << 5) | (((lane >> 5) & 1) << 8); }
constexpr int v_rd_off(int d0, int ks, int half) { return d0 * 512 + ks * 4096 + half * 2048; }
template <int OFF> __device__ __forceinline__ s16x4 tr_read(int vb) {
  s16x4 r; asm volatile("ds_read_b64_tr_b16 %0, %1 offset:%2" : "=&v"(r) : "v"(vb), "i"(OFF) : "memory"); return r;
}
template <int D0> __device__ __forceinline__ void pv_one(f32x16& od, int vb, bf16x8 pa0, bf16x8 pa1, bf16x8 pa2, bf16x8 pa3) {
  const s16x4 l0 = tr_read<v_rd_off(D0, 0, 0)>(vb), h0 = tr_read<v_rd_off(D0, 0, 1)>(vb), l1 = tr_read<v_rd_off(D0, 1, 0)>(vb), h1 = tr_read<v_rd_off(D0, 1, 1)>(vb);
  const s16x4 l2 = tr_read<v_rd_off(D0, 2, 0)>(vb), h2 = tr_read<v_rd_off(D0, 2, 1)>(vb), l3 = tr_read<v_rd_off(D0, 3, 0)>(vb), h3 = tr_read<v_rd_off(D0, 3, 1)>(vb);
  asm volatile("s_waitcnt lgkmcnt(0)" ::: "memory"); SBAR();
#define PK(L, H) (bf16x8){L[0], L[1], L[2], L[3], H[0], H[1], H[2], H[3]}
  od = __builtin_amdgcn_mfma_f32_32x32x16_bf16(pa0, PK(l0, h0), od, 0, 0, 0);
  od = __builtin_amdgcn_mfma_f32_32x32x16_bf16(pa1, PK(l1, h1), od, 0, 0, 0);
  od = __builtin_amdgcn_mfma_f32_32x32x16_bf16(pa2, PK(l2, h2), od, 0, 0, 0);
  od = __builtin_amdgcn_mfma_f32_32x32x16_bf16(pa3, PK(l3, h3), od, 0, 0, 0);
#undef PK
}
template <int ND> __device__ __forceinline__ void pv_all(f32x16* o, int vb, bf16x8 pa0, bf16x8 pa1, bf16x8 pa2, bf16x8 pa3) {
  pv_one<0>(o[0], vb, pa0, pa1, pa2, pa3); pv_one<1>(o[1], vb, pa0, pa1, pa2, pa3);
  if constexpr (ND == 4) { pv_one<2>(o[2], vb, pa0, pa1, pa2, pa3); pv_one<3>(o[3], vb, pa0, pa1, pa2, pa3); }
}

struct TileSrc { const bf16* k; const bf16* v; int ld; int kpos0; };
template <int MODE> __device__ __forceinline__ TileSrc tile_src(const Frame& F, int path, int b, int hh, int qb, int j) {
  TileSrc t; t.kpos0 = -1;
  if (MODE == 0) {
    if (path == 0 || j < 32) { const long row0 = (path ? NCTX + (long)b * 2048 : (long)b * 256) + j * 64;
      t.k = F.PROJ() + row0 * LDP + C_KA + hh * 128; t.v = F.PROJ() + row0 * LDP + C_VA + hh * 128; t.ld = LDP; }
    else { const long r0 = (long)b * 256 + (j - 32) * 64; t.k = F.CKA() + r0 * 512 + hh * 128; t.v = F.CVA() + r0 * 512 + hh * 128; t.ld = 512; }
  } else {
    if (path == 0) { const long row0 = (long)b * 256 + j * 64; t.k = F.PROJ() + row0 * LDP + C_KB + hh * 64; t.v = F.PROJ() + row0 * LDP + C_VB + hh * 64; t.ld = LDP; }
    else {
      const int nloc = 2 + (qb > 0 ? 2 : 0) + (qb < 15 ? 2 : 0);
      if (j < nloc) { int kt; if (j < 2) kt = 2 * qb + j; else if (qb > 0 && j < 4) kt = 2 * qb - 2 + (j - 2); else kt = 2 * qb + 2 + (j - (qb > 0 ? 4 : 2));
        const long row0 = NCTX + (long)b * 2048 + kt * 64; t.k = F.PROJ() + row0 * LDP + C_KB + hh * 64; t.v = F.PROJ() + row0 * LDP + C_VB + hh * 64; t.ld = LDP; t.kpos0 = kt * 64; }
      else { const long r0 = (long)b * 256 + (j - nloc) * 64; t.k = F.CKB() + r0 * 128 + hh * 64; t.v = F.CVB() + r0 * 128 + hh * 64; t.ld = 128; }
    }
  }
  return t;
}
template <int MODE> struct Stg;
template <> struct Stg<0> { bf16x8 vs0, vs1, ks0, ks1; };
template <> struct Stg<1> { bf16x8 vs0, ks0; };

template <int MODE>
__device__ __forceinline__ void attn_unit(const Frame& F, int layer, int path, int b, int hh, int qb, char* lds) {
  constexpr int ND = MODE == 0 ? 4 : 2;
  int tid_ = threadIdx.x; asm volatile("" : "+v"(tid_));
  const int tid = tid_, wid = __builtin_amdgcn_readfirstlane(tid >> 6), lane = tid & 63, r32 = lane & 31, hi = lane >> 5;
  const int wq = wid & 3, wc = wid >> 2;
  char* V_lds = lds; char* K_lds = lds + 2 * SHM_V;
  float* ws = (float*)(lds + LDS_WS) + wid * 64; float* li_l = ws; float* al_l = ws + 32;
  const long rowbase = path ? NCTX + (long)b * 2048 : (long)b * 256;
  const long qrow0 = rowbase + qb * 128 + wq * 32;
  const int qcol = MODE == 0 ? C_QA + hh * 128 + wc * 64 : C_QB + (hh * 2 + wc) * 64;
  const int kcb = MODE == 0 ? wc * 128 : 0;
  const int NT = MODE == 0 ? (path ? 36 : 4) : (path ? 6 + (qb > 0 ? 2 : 0) + (qb < 15 ? 2 : 0) : 4);
  const int qpos = qb * 128 + wq * 32 + r32;
  float m_reg = -1e30f, l_reg = 0; f32x16 o[ND]; bf16x8 qr[4];
#pragma unroll
  for (int d = 0; d < ND; ++d) o[d] = f32x16{};
  { const bf16* Qw = F.PROJ() + (qrow0 + r32) * LDP + qcol + hi * 8;
#pragma unroll
    for (int d0 = 0; d0 < 4; ++d0) qr[d0] = ld8(Qw + d0 * 16); }
  const int sr = MODE == 0 ? (tid >> 4) : (tid >> 3), sc = MODE == 0 ? (tid & 15) * 8 : (tid & 7) * 8;
  const int vst0 = v_st(sr, sc), vst1 = v_st(32 + sr, sc);
  const int vb0 = (int)(uintptr_t)V_lds + v_rd_base(lane);
  Stg<MODE> sr_[2];
#define SLOAD(i, j_) do { const TileSrc ts_ = tile_src<MODE>(F, path, b, hh, qb, (j_)); \
    sr_[i].vs0 = ld8(ts_.v + (long)sr * ts_.ld + sc); sr_[i].ks0 = ld8(ts_.k + (long)sr * ts_.ld + sc); \
    if constexpr (MODE == 0) { sr_[i].vs1 = ld8(ts_.v + (long)(32 + sr) * ts_.ld + sc); sr_[i].ks1 = ld8(ts_.k + (long)(32 + sr) * ts_.ld + sc); } } while (0)
#define SWRITE(bb, i) do { *(bf16x8*)(V_lds + (bb) * SHM_V + vst0) = sr_[i].vs0; *(bf16x8*)(K_lds + (bb) * SHM_K + KSWZ(sr, sc * 2)) = sr_[i].ks0; \
    if constexpr (MODE == 0) { *(bf16x8*)(V_lds + (bb) * SHM_V + vst1) = sr_[i].vs1; *(bf16x8*)(K_lds + (bb) * SHM_K + KSWZ(32 + sr, sc * 2)) = sr_[i].ks1; } } while (0)
#define RESC(a) do { if (__any((a) < 1.f)) { if (hi == 0) al_l[r32] = (a); asm volatile("s_waitcnt lgkmcnt(0)" ::: "memory"); \
    _Pragma("unroll") for (int d = 0; d < ND; ++d) _Pragma("unroll") for (int r = 0; r < 16; ++r) o[d][r] *= al_l[crow(r, hi)]; } } while (0)
#define MASK(P0, P1, j_) do { if (MODE == 1 && path == 1) { const TileSrc tm_ = tile_src<MODE>(F, path, b, hh, qb, (j_)); if (tm_.kpos0 >= 0) { \
    _Pragma("unroll") for (int r = 0; r < 16; ++r) { const int kp = tm_.kpos0 + crow(r, hi); int d0_ = kp - qpos; d0_ = d0_ < 0 ? -d0_ : d0_; int d1_ = kp + 32 - qpos; d1_ = d1_ < 0 ? -d1_ : d1_; \
      if (d0_ > 128) P0[r] = -__builtin_inff(); if (d1_ > 128) P1[r] = -__builtin_inff(); } } } } while (0)
  f32x16 pA0, pA1, pB0, pB1; float mnA, mnB, alA, alB; bf16x8 pa0, pa1, pa2, pa3;
  SLOAD(0, 0); asm volatile("s_waitcnt vmcnt(0)" ::: "memory"); SWRITE(0, 0); __syncthreads();
  qkt(pA0, pA1, K_lds, qr, r32, hi, kcb); MASK(pA0, pA1, 0); partialSM(pA0, pA1, m_reg, mnA, alA);
  SLOAD(1, 1); if (2 < NT) SLOAD(0, 2);
  SWRITE(1, 1); __syncthreads();
  for (int j = 1; j + 1 < NT; j += 2) {
    SBAR(); qkt(pB0, pB1, K_lds + SHM_K, qr, r32, hi, kcb);
    finishSM(pA0, pA1, alA, l_reg, pa0, pa1, pa2, pa3); SBAR();
    SLOAD(1, j + 2); SBAR();
    pv_all<ND>(o, vb0, pa0, pa1, pa2, pa3); MASK(pB0, pB1, j); partialSM(pB0, pB1, m_reg, mnB, alB);
    __syncthreads(); SWRITE(0, 0);
    RESC(alB); __syncthreads();
    SBAR(); qkt(pA0, pA1, K_lds, qr, r32, hi, kcb);
    finishSM(pB0, pB1, alB, l_reg, pa0, pa1, pa2, pa3); SBAR();
    if (j + 3 < NT) SLOAD(0, j + 3); SBAR();
    pv_all<ND>(o, vb0 + SHM_V, pa0, pa1, pa2, pa3); MASK(pA0, pA1, j + 1); partialSM(pA0, pA1, m_reg, mnA, alA);
    __syncthreads(); SWRITE(1, 1);
    RESC(alA); __syncthreads();
  }
  SBAR(); qkt(pB0, pB1, K_lds + SHM_K, qr, r32, hi, kcb);
  finishSM(pA0, pA1, alA, l_reg, pa0, pa1, pa2, pa3); SBAR();
  pv_all<ND>(o, vb0, pa0, pa1, pa2, pa3); MASK(pB0, pB1, NT - 1); partialSM(pB0, pB1, m_reg, mnB, alB);
  __syncthreads(); RESC(alB);
  finishSM(pB0, pB1, alB, l_reg, pa0, pa1, pa2, pa3); SBAR();
  pv_all<ND>(o, vb0 + SHM_V, pa0, pa1, pa2, pa3);
#undef SLOAD
#undef SWRITE
#undef RESC
#undef MASK
  constexpr float C = SCALE * 1.4426950408889634f;
  if (MODE == 1) { const float sk = in_ptr(17)[layer * 4 + hh * 2 + wc]; l_reg += __builtin_amdgcn_exp2f(sk * 1.4426950408889634f - m_reg * C); }
  if (hi == 0) li_l[r32] = l_reg; asm volatile("s_waitcnt lgkmcnt(0)" ::: "memory");
  float rli[16];
#pragma unroll
  for (int r = 0; r < 16; ++r) rli[r] = __builtin_amdgcn_rcpf(li_l[crow(r, hi)]);
  if (MODE == 0) {
    const float lam = F.ROPE()[2048 + layer * 2], omli = F.ROPE()[2048 + layer * 2 + 1];
    float* X = (float*)lds;
    __syncthreads();
    if (wc == 1) {
#pragma unroll
      for (int d = 0; d < 4; ++d)
#pragma unroll
        for (int r = 0; r < 16; ++r) X[((wq * 4 + d) * 16 + r) * 64 + lane] = o[d][r] * rli[r] * lam;
    }
    __syncthreads();
    if (wc == 0) {
      const float* dg = in_ptr(16) + layer * 128;
      float dgv[4];
#pragma unroll
      for (int d = 0; d < 4; ++d) dgv[d] = dg[32 * d + r32] * omli;
#pragma unroll
      for (int r = 0; r < 16; ++r) {
        float v[4]; float ss = 0.f;
#pragma unroll
        for (int d = 0; d < 4; ++d) { v[d] = o[d][r] * rli[r] - X[((wq * 4 + d) * 16 + r) * 64 + lane]; ss += v[d] * v[d]; }
#pragma unroll
        for (int off = 1; off < 32; off <<= 1) ss += __shfl_xor(ss, off);
        const float rstd = 1.f / sqrtf(ss * (1.f / 128.f) + RMS_EPS);
        const long row = qrow0 + crow(r, hi);
        const bf16* zr = F.PROJ() + row * LDP + C_Z + hh * 128 + r32;
        bf16* mr = F.ACT() + row * DM + hh * 128 + r32;
#pragma unroll
        for (int d = 0; d < 4; ++d) mr[32 * d] = (bf16)f2bf(v[d] * rstd * dgv[d] * bf2f(zr[32 * d]));
      }
    }
    __syncthreads();
  } else {
#pragma unroll
    for (int r = 0; r < 16; ++r) {
      const long row = qrow0 + crow(r, hi);
      const int mc = 512 + (hh * 2 + wc) * 64 + r32;
      const bf16* zr = F.PROJ() + row * LDP + C_Z + mc;
      bf16* mr = F.ACT() + row * DM + mc;
#pragma unroll
      for (int d = 0; d < 2; ++d) mr[32 * d] = (bf16)f2bf(o[d][r] * rli[r] * bf2f(zr[32 * d]));
    }
    __syncthreads();
  }
}

__device__ __forceinline__ void fourier_unit(const Frame& F, int path, int b, int kb, int cb, char* lds) {
  int tid_ = threadIdx.x; asm volatile("" : "+v"(tid_));
  const int tid = tid_, wid = __builtin_amdgcn_readfirstlane(tid >> 6), lane = tid & 63, r32 = lane & 31, hi = lane >> 5;
  char* V_lds = lds;
  const int S = path ? 2048 : 256, TPP = S / 64, NT = 2 * TPP;
  const long rowbase = path ? NCTX + (long)b * 2048 : (long)b * 256;
  const int k0 = kb * 256 + wid * 32;
  const bf16* Dm = (path ? F.DFTL() : F.DFTC()) + (long)(k0 + r32) * (2 * S) + hi * 8;
  const int sr = tid >> 3, sc = (tid & 7) * 8;
  const int vst0 = v_st(sr, sc);
  const int vb0 = (int)(uintptr_t)V_lds + v_rd_base(lane);
  f32x16 o[2]; o[0] = f32x16{}; o[1] = f32x16{};
  bf16x8 a0, a1, a2, a3, n0, n1, n2, n3, vreg;
#define FV_SRC(j_) (F.PROJ() + (rowbase + ((j_) % TPP) * 64 + sr) * LDP + C_VF + ((j_) / TPP) * 256 + cb * 64 + sc)
#define FA_LOAD(A0, A1, A2, A3, j_) do { const bf16* p_ = Dm + ((j_) / TPP) * S + ((j_) % TPP) * 64; A0 = ld8(p_); A1 = ld8(p_ + 16); A2 = ld8(p_ + 32); A3 = ld8(p_ + 48); } while (0)
  vreg = ld8(FV_SRC(0)); FA_LOAD(a0, a1, a2, a3, 0);
  *(bf16x8*)(V_lds + vst0) = vreg; __syncthreads();
  for (int j = 0; j < NT; ++j) {
    const bool more = j + 1 < NT;
    if (more) { vreg = ld8(FV_SRC(j + 1)); FA_LOAD(n0, n1, n2, n3, j + 1); }
    pv_all<2>(o, vb0 + (j & 1) * SHM_V, a0, a1, a2, a3);
    if (more) { *(bf16x8*)(V_lds + ((j + 1) & 1) * SHM_V + vst0) = vreg; a0 = n0; a1 = n1; a2 = n2; a3 = n3; }
    __syncthreads();
  }
#undef FV_SRC
#undef FA_LOAD
#pragma unroll
  for (int r = 0; r < 16; ++r) {
    const long row = rowbase + k0 + crow(r, hi);
    const int mc = 768 + cb * 64 + r32;
    const bf16* zr = F.PROJ() + row * LDP + C_Z + mc;
    bf16* mr = F.ACT() + row * DM + mc;
#pragma unroll
    for (int d = 0; d < 2; ++d) mr[32 * d] = (bf16)f2bf(o[d][r] * bf2f(zr[32 * d]));
  }
}
#undef KSWZ
#undef SBAR
}

__device__ __forceinline__ void phase_prologue(Frame& F) {
    const int G = F.G, bid = blockIdx.x, tid = F.tid;
    {
        LAS float* sc = (LAS float*)(F.lds + RING_OFF);
        LAS float* red = (LAS float*)(F.lds + RING_OFF + 9 * 1024 * 4);
        bool have = false;
        for (int job = bid; job < 192; job += G) {
            if (!have) { for (int i = tid; i < 9 * 1024; i += 512) { const int p = i >> 10, k = i & 1023; const float v = p == 0 ? in_ptr(7)[k] : in_ptr(6)[(p - 1) * 1024 + k]; sc[i] = silu_f(v); } have = true; }
            __syncthreads();
            const int l = job / 48, j0 = (job % 48) * 64, ks = tid >> 6, jj = tid & 63;
            float acc[9];
#pragma unroll
            for (int p = 0; p < 9; ++p) acc[p] = 0.f;
            const float* wp = in_ptr(8) + ((size_t)l * 1024 + ks * 128) * 3072 + j0 + jj;
#pragma unroll 8
            for (int kk = 0; kk < 128; ++kk) { const float w = wp[(size_t)kk * 3072];
#pragma unroll
                for (int p = 0; p < 9; ++p) acc[p] += sc[p * 1024 + ks * 128 + kk] * w; }
#pragma unroll
            for (int p = 0; p < 9; ++p) red[(ks * 64 + jj) * 9 + p] = acc[p];
            __syncthreads();
            for (int i = tid; i < 64 * 9; i += 512) { const int j2 = i / 9, p = i % 9; float s = 0.f;
#pragma unroll
                for (int q = 0; q < 8; ++q) s += red[(q * 64 + j2) * 9 + p];
                F.MOD()[((size_t)l * 9 + p) * 3072 + j0 + j2] = s + in_ptr(9)[l * 3072 + j0 + j2]; }
        }
        __syncthreads();
    }
    const long gt = (long)bid * 512 + tid, NGT = (long)G * 512;
    for (long i = gt; i < 4 * 4 * 64 * 128; i += NGT) {
        const int n2 = (int)(i & 127), c = (int)((i >> 7) & 63), lg = (int)(i >> 13); const int ri = n2 >> 6, d = n2 & 63;
        const float* wf = in_ptr(18) + (size_t)lg * 4096 + d; float s = 0.f;
        for (int j = 0; j < 64; ++j) { const float ang = (float)((j * c) & 63) * (6.283185307179586f / 64.f); const float t = ri ? -sinf(ang) : cosf(ang); s += t * wf[j * 64]; }
        F.GF()[i] = s * 0.125f;
    }
    for (long i = gt; i < 1024; i += NGT) { const int pos = (int)(i >> 4), fi = (int)(i & 15); const float inv = powf(10000.f, -(float)fi / 16.f); const float ang = (float)pos * inv; F.ROPE()[i] = cosf(ang); F.ROPE()[1024 + i] = sinf(ang); }
    if (gt < 4) { const int l = (int)gt; float s1 = 0.f, s2 = 0.f;
        for (int k = 0; k < 64; ++k) { s1 += in_ptr(12)[l * 64 + k] * in_ptr(13)[l * 64 + k]; s2 += in_ptr(14)[l * 64 + k] * in_ptr(15)[l * 64 + k]; }
        const float li = 0.8f - 0.6f * expf(-0.3f * (float)l);
        F.ROPE()[2048 + 2 * l] = expf(s1) - expf(s2) + li; F.ROPE()[2048 + 2 * l + 1] = 1.f - li; }
    for (long i = gt; i < 2048L * 4096 / 8; i += NGT) { const int k = (int)(i >> 9), c0 = (int)(i & 511) * 8; const int part = c0 >> 11; v4u o; unsigned short h[8];
#pragma unroll
        for (int e = 0; e < 8; ++e) { const int s = (c0 + e) & 2047; const float ang = (float)((k * s) & 2047) * (6.283185307179586f / 2048.f); const float t = part ? sinf(ang) : cosf(ang); h[e] = (unsigned short)f2bf(t * 0.02209708691207961f); }
        o.x = h[0] | ((unsigned)h[1] << 16); o.y = h[2] | ((unsigned)h[3] << 16); o.z = h[4] | ((unsigned)h[5] << 16); o.w = h[6] | ((unsigned)h[7] << 16);
        *(GAS v4u*)(F.DFTL() + i * 8) = o; }
    for (long i = gt; i < 256L * 512 / 8; i += NGT) { const int k = (int)(i >> 6), c0 = (int)(i & 63) * 8; const int part = c0 >> 8; v4u o; unsigned short h[8];
#pragma unroll
        for (int e = 0; e < 8; ++e) { const int s = (c0 + e) & 255; const float ang = (float)((k * s) & 255) * (6.283185307179586f / 256.f); const float t = part ? sinf(ang) : cosf(ang); h[e] = (unsigned short)f2bf(t * 0.0625f); }
        o.x = h[0] | ((unsigned)h[1] << 16); o.y = h[2] | ((unsigned)h[3] << 16); o.z = h[4] | ((unsigned)h[5] << 16); o.w = h[6] | ((unsigned)h[7] << 16);
        *(GAS v4u*)(F.DFTC() + i * 8) = o; }
}
__device__ __forceinline__ void phase_norm(Frame& F, int l) {
    int tid_ = threadIdx.x, bid_ = blockIdx.x; asm volatile("" : "+v"(tid_)); asm volatile("" : "+s"(bid_));
    const int ptid = tid_, plane = tid_ & 63, pwave = __builtin_amdgcn_readfirstlane(tid_ >> 6);
    const int gw = bid_ * NWAVES + pwave, NGW = F.G * NWAVES;
    float* X = F.out;
    if (l == DEPTH) { for (int m = gw; m < MTOK; m += NGW) norm_row<true>(X + (size_t)m * DM, nullptr, X + (size_t)m * DM, in_ptr(20), nullptr, nullptr, plane); return; }
    {
        LAS float* scr = (LAS float*)(F.lds + RING_OFF + pwave * 16384);
        constexpr int I_IN = 16 * 104, I_OUT = 16 * 32, I_FOLD = 256, NITEMS = I_FOLD + I_IN + I_OUT;
        const float* win_l = in_ptr(11) + (size_t)l * DM * NIN; const float* wout_l = in_ptr(19) + (size_t)l * DM * DM;
        for (int it = gw; it < NITEMS; it += NGW) {
            int r = it;
            if (r < I_FOLD) { fold_item(win_l, F.GF() + (size_t)l * 4 * 64 * 128, F.WIN(), r, plane); continue; } r -= I_FOLD;
            if (r < I_IN) { const int nb = r % 104; if (nb >= 64 && nb < 72) continue; p0_transpose_item(win_l, DM, NIN, F.WIN(), nb >= 72 ? 256 : 0, scr, r, plane); continue; } r -= I_IN;
            p0_transpose_item(wout_l, DM, DM, F.WOUT(), 0, scr, r, plane);
        }
    }
    {
        const long gt = (long)bid_ * 512 + ptid, NGT = (long)F.G * 512;
        constexpr long NA = 8L * 256 * 512 / 8, NB = 8L * 256 * 128 / 8;
        for (long i = gt; i < 2 * NA + 2 * NB; i += NGT) {
            const float* src; bf16* dst; long e;
            if (i < 2 * NA) { const bool isv = i >= NA; e = (isv ? i - NA : i) * 8; const long b = e / (256 * 512), r = e % (256 * 512); src = in_ptr(isv ? 3 : 2) + ((b * 4 + l) * 256L * 512) + r; dst = (isv ? F.CVA() : F.CKA()) + e; }
            else { const long i2 = i - 2 * NA; const bool isv = i2 >= NB; e = (isv ? i2 - NB : i2) * 8; const long b = e / (256 * 128), r = e % (256 * 128); src = in_ptr(isv ? 5 : 4) + ((b * 4 + l) * 256L * 128) + r; dst = (isv ? F.CVB() : F.CKB()) + e; }
            const f32x4 a = *(const f32x4*)src, c = *(const f32x4*)(src + 4);
            v4u o; o.x = pk2(a.x, a.y); o.y = pk2(a.z, a.w); o.z = pk2(c.x, c.y); o.w = pk2(c.z, c.w);
            *(GAS v4u*)dst = o;
        }
    }
    const float* ng = in_ptr(10) + l * DM;
    for (int m = gw; m < MTOK; m += NGW) {
        const bool ctx = m < NCTX; const int p = ctx ? 0 : 1 + ((m - NCTX) >> 11);
        const float* mp = F.MOD() + ((size_t)l * 9 + p) * 3072;
        const float* xrow = l == 0 ? (ctx ? in_ptr(0) + (size_t)m * DM : in_ptr(1) + (size_t)(m - NCTX) * DM) : X + (size_t)m * DM;
        norm_row<false>(xrow, F.ACT() + (size_t)m * DM, nullptr, ng, mp + 1024, mp, plane);
    }
}
__device__ __forceinline__ void phase_mix(Frame& F, int l, char* lds) {
    int bid_ = blockIdx.x; asm volatile("" : "+s"(bid_));
    for (int u = bid_; u < 1536; u += F.G) {
        const int seg = u >> 8, within = u & 255, x = within & 7, li = within >> 3;
        int type, path, b, hh, qb, kb = 0;
        if (seg < 2) { const int idx = seg * 32 + li, j = idx >> 4; qb = idx & 15; const int bh = x + 8 * j; b = bh >> 2; hh = bh & 3; type = 0; path = 1; }
        else if (seg == 2) { type = 2; path = 1; b = x; kb = li >> 2; hh = li & 3; qb = 0; }
        else if (seg == 3) { type = 1; path = 1; b = x; hh = li >> 4; qb = li & 15; }
        else if (seg == 4) { const int id = x * 32 + li; type = 0; path = 0; b = id >> 3; hh = (id >> 1) & 3; qb = id & 1; }
        else if (li < 16) { const int id = x * 16 + li; type = 2; path = 0; b = id >> 2; hh = id & 3; qb = 0; }
        else { const int id = x * 16 + li - 16; type = 1; path = 0; b = id >> 2; hh = (id >> 1) & 1; qb = id & 1; }
#ifndef NO_A0
        if (type == 0) att::attn_unit<0>(F, l, path, b, hh, qb, lds);
#endif
#ifndef NO_A1
        if (type == 1) att::attn_unit<1>(F, l, path, b, hh, qb, lds);
#endif
#ifndef NO_FU
        if (type == 2) att::fourier_unit(F, path, b, kb, hh, lds);
#endif
    }
}

struct Args { const float* in[21]; float* out; unsigned char* ws; };
__global__ void __launch_bounds__(NWAVES * 64, 2) mk_fwd(Args args) {
    extern __shared__ __attribute__((aligned(16))) unsigned char lds[];
    Frame F;
    F.lds = (LAS unsigned char*)lds;
    F.tid = threadIdx.x; F.lane = F.tid & 63; F.wave = __builtin_amdgcn_readfirstlane(F.tid >> 6);
    F.G = gridDim.x;
    unsigned char* ws = args.ws;
    F.out = args.out; F.ws = ws;
    for (int u = F.tid; u < (LDS_BYTES - LDSCTL_OFF) / 4; u += NWAVES * 64) ((LAS unsigned*)(F.lds + LDSCTL_OFF))[u] = 0u;
    __syncthreads();
    (void)xcd_barrier_post((unsigned*)ws + CW_BAR, (volatile LAS unsigned*)(F.lds + MISC_OFF) + 8);
#define GRID_BAR() do { XcdBarrier bar_; bar_.bar = (unsigned*)F.ws + CW_BAR; bar_.x = xb_xcc_id(); bar_.st = (volatile LAS unsigned*)(F.lds + MISC_OFF) + 8; xcd_barrier(bar_); } while (0)

#ifndef NO_PRO
    phase_prologue(F);
#endif
    GRID_BAR();
    for (int l = 0; l < DEPTH; ++l) {
#ifndef NO_NORM
        phase_norm(F, l);
#endif
        GRID_BAR();
        {
            pg8::Gemm g{F.ACT(), F.WIN(), MTOK, LDP, DM}; pg8::StaticOrder S; S.init(MTOK, LDP, F.G, (int)blockIdx.x);
            pg8::EpiInProj E{F.ws, F.out, l};
#ifndef NO_INP
            pg8::gemm_phase<pg8::EpiInProj, pg8::StaticOrder, true, true>(F.lds + RING_OFF, g, S, E);
#endif
        }
        GRID_BAR();
#ifndef NO_MIX
        phase_mix(F, l, (char*)lds + RING_OFF);
#endif
        GRID_BAR();
        {
            pg8::Gemm g{F.ACT(), F.WOUT(), MTOK, DM, DM}; pg8::StaticOrder S; S.init(MTOK, DM, F.G, (int)blockIdx.x);
            pg8::EpiOutProj E{F.ws, F.out, l};
#ifndef NO_OUTP
            pg8::gemm_phase<pg8::EpiOutProj, pg8::StaticOrder, true, true>(F.lds + RING_OFF, g, S, E);
#endif
        }
        GRID_BAR();
    }
#ifndef NO_NORM
    phase_norm(F, DEPTH);
#endif
#undef GRID_BAR
}

extern "C" void kernel_launch(void* const* d_in, const int* in_sizes, int n_in, void* d_out, int out_size, void* d_ws, size_t ws_size, hipStream_t stream) {
    static int grid = 0;
    if (grid == 0) {
        if (n_in != 21 || ws_size < WS_END) { fprintf(stderr, "kernel_launch: built for 21 inputs and >= %zu bytes of workspace; got n_in %d, ws %zu\n", (size_t)WS_END, n_in, ws_size); grid = -1; return; }
        int dev = 0, cus = 0, per_cu = 0;
        if (hipGetDevice(&dev) != hipSuccess || hipDeviceGetAttribute(&cus, hipDeviceAttributeMultiprocessorCount, dev) != hipSuccess) { grid = -1; return; }
        if (hipFuncSetAttribute((const void*)mk_fwd, hipFuncAttributeMaxDynamicSharedMemorySize, LDS_BYTES) != hipSuccess) { fprintf(stderr, "kernel_launch: hipFuncSetAttribute failed\n"); grid = -1; return; }
        if (hipOccupancyMaxActiveBlocksPerMultiprocessor(&per_cu, (const void*)mk_fwd, NWAVES * 64, LDS_BYTES) != hipSuccess || per_cu < 1) fprintf(stderr, "kernel_launch: occupancy query reports %d\n", per_cu);
        (void)hipGetLastError();
        grid = cus;
    }
    if (grid < 0) return;
    if (hipMemsetAsync((char*)d_ws + WS_CTL, 0, CTL_ZERO_BYTES, stream) != hipSuccess) return;
    Args a{};
    for (int i = 0; i < 21; ++i) a.in[i] = (const float*)d_in[i];
    a.out = (float*)d_out; a.ws = (unsigned char*)d_ws;
    hipLaunchKernelGGL(mk_fwd, dim3(grid), dim3(NWAVES * 64), LDS_BYTES, stream, a);
    const hipError_t le = hipPeekAtLastError();
    if (le != hipSuccess) fprintf(stderr, "kernel_launch: launch failed: %s\n", hipGetErrorName(le));
}
```

```cpp
#include <hip/hip_runtime.h>
#include <cstdio>
#include <cstdint>
#include <cmath>
constexpr int DM = 1024, NCTX = 8192, NLAT = 16384, MTOK = NCTX + NLAT, DEPTH = 4, LDP = 2304, NPROJ = 3584, NIN = 3328;
constexpr int C_QA = 0, C_QB = 512, C_VF = 768, C_Z = 1280;
constexpr int NWAVES = 8;
constexpr float RMS_EPS = 1e-6f;
constexpr float QSCALE = 0.125f * 1.4426950408889634f;
constexpr size_t MiB = 1u << 20;
constexpr size_t WS_CTL = 0, CTL_ZERO_BYTES = 1 * MiB;
constexpr size_t WS_MOD = 1 * MiB;
constexpr size_t WS_G = WS_MOD + MiB / 2;
constexpr size_t WS_ROPE = 2 * MiB;
constexpr size_t WS_DFTC = 2 * MiB + MiB / 4;
constexpr size_t WS_FM1 = 3 * MiB;
constexpr size_t WS_FM2 = WS_FM1 + 8192;
constexpr size_t WS_FT2 = WS_FM2 + 16384;
constexpr size_t WS_ROWSS = MiB / 2;
constexpr size_t WS_GS = 2 * MiB + 65536;
constexpr size_t WS_BIAS = 2 * MiB + MiB / 2;
constexpr size_t WS_WIN = 4 * MiB;
constexpr size_t WS_WOUT = 11 * MiB, WOUT_BYTES = 2 * MiB;
constexpr size_t WS_ACT = 15 * MiB;
constexpr size_t WS_PROJ = 63 * MiB;
constexpr size_t WS_KAL = 171 * MiB, WS_VAL = 189 * MiB;
constexpr size_t WS_KAC = 207 * MiB, WS_VAC = 215 * MiB;
constexpr size_t WS_KBL = 223 * MiB, WS_VBL = WS_KBL + 9 * MiB / 2;
constexpr size_t WS_KBC = 232 * MiB, WS_VBC = 234 * MiB;
constexpr size_t WS_VFT = 236 * MiB;
constexpr size_t WS_END = 252 * MiB;
static_assert(WS_PROJ + (size_t)MTOK * LDP * 2 <= WS_KAL && WS_ACT + (size_t)MTOK * DM * 2 <= WS_PROJ && WS_KAL + 8ull * 4 * 2304 * 128 * 2 <= WS_VAL && WS_KBL + 8ull * 2 * 2304 * 64 * 2 <= WS_VBL && WS_VBL + 8ull * 2 * 2304 * 64 * 2 <= WS_KBC && WS_VBC + 32ull * 2 * 256 * 64 * 2 <= WS_VFT && WS_VFT + 8ull * 32 * 2 * 2048 * 8 * 2 <= WS_END, "ws map");
static_assert(WS_WIN + (size_t)NPROJ * DM * 2 <= WS_WOUT && WS_WOUT + 2 * WOUT_BYTES <= WS_ACT, "ws map (weights)");
constexpr int CW_BAR = 4096;
constexpr int RING_OFF = 0, RING_BYTES = 131072;
constexpr int LDSCTL_OFF = RING_BYTES, MISC_OFF = LDSCTL_OFF + 320;
constexpr int LDS_BYTES = 147456;

typedef const float* cfp_t;
typedef __attribute__((address_space(4))) const char* kaptr_t;
typedef __attribute__((address_space(4))) const cfp_t* kcfp_t;
__device__ __forceinline__ const float* in_ptr(int i) {
    kaptr_t ka = (kaptr_t)__builtin_amdgcn_kernarg_segment_ptr();
    asm volatile("" : "+s"(ka));
    return *(kcfp_t)(ka + 8 * i);
}
namespace pg8 {
#define PG8_LAS __attribute__((address_space(3)))
typedef unsigned short bf16_t;
typedef short bf16x8 __attribute__((ext_vector_type(8)));
typedef float f32x4 __attribute__((ext_vector_type(4)));
typedef unsigned u32x4 __attribute__((ext_vector_type(4)));
constexpr int BM = 256, BK = 64, HALF = 128, HTB = HALF * BK * 2  , STAGE_BYTES = 8 * HTB, NXCD = 8, WGM = 8;

__host__ __device__ __forceinline__ int lds_byte(int r, int c) { const int st = (r >> 4) * 2 + (c >> 5), rr = r & 15, cc = c & 31, ob = rr * 64 + cc * 2; return st * 1024 + (ob ^ (((ob >> 9) & 1) << 5)); }
__host__ __device__ __forceinline__ void stage_rc(int b, int& R, int& C) { const int st = b / 1024, sb = b % 1024, swz = sb ^ (((sb >> 9) & 1) << 5); R = (st >> 1) * 16 + swz / 64; C = (st & 1) * 32 + (swz % 64) / 2; }
__host__ __device__ __forceinline__ int perm32(int rho) { const int n = rho >> 4, i = rho & 15; return 8 * (i >> 2) + 4 * n + (i & 3); }

struct Unit { int pm, pn; };
struct Gemm { const bf16_t* A; const bf16_t* Bt; int M, N, K, lda; };

struct StaticOrder {
    int nM, nN, nwg, G, c, pm0;
    __host__ __device__ void init(int M, int N, int G_, int c_, int pm0_ = 0) { nM = M / BM; nN = N / BM; nwg = nM * nN; G = G_; c = c_; pm0 = pm0_; }
    __host__ __device__ bool next(int i, Unit& u) const {
        const long L = (long)i * G + c; if (L >= nwg) return false;
        int wgid = (int)L; { const int q = nwg / NXCD, r = nwg % NXCD, xcd = wgid % NXCD, off = wgid / NXCD; wgid = (xcd < r ? xcd * (q + 1) : r * (q + 1) + (xcd - r) * q) + off; }
        const int nig = WGM * nN, gid = wgid / nig, fm = gid * WGM, gsz = (nM - fm) < WGM ? (nM - fm) : WGM;
        u.pm = pm0 + fm + ((wgid % nig) % gsz); u.pn = (wgid % nig) / gsz; return true;
    }
    __device__ __forceinline__ void a_ready(const Unit&) const {}
    __device__ __forceinline__ void done(const Unit&) const {}
};

__device__ __forceinline__ unsigned cvt_pk_bf16(float lo, float hi) { unsigned r; asm volatile("v_cvt_pk_bf16_f32 %0, %1, %2" : "=v"(r) : "v"(lo), "v"(hi)); return r; }
struct EpiInProj {
    static constexpr bool PERM = true, AFTER_DRAIN = false;
    unsigned char* ws; float* out; int layer;
    __device__ __forceinline__ void operator()(const f32x4 (&acc)[2][2][4][2], const Unit& u, int wr, int wc, int fr_, int fq_) const {
        int fr = fr_, fq = fq_; asm volatile("" : "+v"(fr), "+v"(fq));
        const bool ctx = u.pm < 32;
        bf16_t* P = (bf16_t*)(ws + WS_PROJ); const float* rcos = (const float*)(ws + WS_ROPE); const float* rsin = rcos + 1024;
        float* o_dk = out + (size_t)MTOK * DM; float* o_dv = o_dk + 32L * 4 * 256 * 512; float* o_sk = o_dv + 32L * 4 * 256 * 512; float* o_sv = o_sk + 32L * 4 * 256 * 128;
#pragma unroll
        for (int bj = 0; bj < 2; ++bj) {
            const int colb = u.pn * 256 + bj * 128;
            const int col0 = colb + wc * 32 + 8 * fq;
            const bool rope = !ctx && (colb < 1024 || (colb >= 1536 && colb < 1920));
            const bool silu = colb >= 2560;
            const int bb = ctx ? u.pm : (u.pm - 32) >> 3, s0 = ctx ? 0 : ((u.pm - 32) & 7) * 256, SL = ctx ? 256 : 2304;
            bf16_t* dbase; int dld;
            if (colb < 512) { dbase = P + (size_t)u.pm * 256 * LDP + col0; dld = LDP; }
            else if (colb < 1536) { const bool isv = colb >= 1024; const int h = ((colb - 512) >> 7) & 3;
                bf16_t* kv = (bf16_t*)(ws + (ctx ? (isv ? WS_VAC : WS_KAC) : (isv ? WS_VAL : WS_KAL)));
                dbase = kv + ((size_t)(bb * 4 + h) * SL + s0) * 128 + wc * 32 + 8 * fq; dld = 128; }
            else if (colb < 1792) { dbase = P + (size_t)u.pm * 256 * LDP + C_QB + (col0 - 1536); dld = LDP; }
            else if (colb < 2048) { const bool isv = colb >= 1920; const int kvh = wc >> 1;
                bf16_t* kv = (bf16_t*)(ws + (ctx ? (isv ? WS_VBC : WS_KBC) : (isv ? WS_VBL : WS_KBL)));
                dbase = kv + ((size_t)(bb * 2 + kvh) * SL + s0) * 64 + (wc & 1) * 32 + 8 * fq; dld = 64; }
            else if (colb < 2560) {
                if (ctx) { dbase = P + (size_t)u.pm * 256 * LDP + C_VF + (col0 - 2048); dld = LDP; }
                else { const int vc = col0 - 2048, cs = (vc & 255) >> 3, ri = vc >> 8;
                    dbase = (bf16_t*)(ws + WS_VFT) + ((size_t)((bb * 32 + cs) * 2 + ri) * 2048 + s0) * 8; dld = 8; } }
            else { dbase = P + (size_t)u.pm * 256 * LDP + C_Z + (col0 - 2560); dld = LDP; }
            float* fo = nullptr; int fld = 0, fcol = 0;
            if (ctx) {
                if (colb >= 512 && colb < 1024) { fo = o_dk; fld = 512; fcol = col0 - 512; }
                else if (colb >= 1024 && colb < 1536) { fo = o_dv; fld = 512; fcol = col0 - 1024; }
                else if (colb == 1792) { fo = o_sk; fld = 128; fcol = col0 - 1792; }
                else if (colb == 1920) { fo = o_sv; fld = 128; fcol = col0 - 1920; }
            }
            const float sgn = (fq < 2) ? -1.f : 1.f;
            const int ti = 8 * (fq & 1);
#pragma unroll
            for (int ai = 0; ai < 2; ++ai)
#pragma unroll
                for (int m = 0; m < 4; ++m) {
                    const int row = u.pm * 256 + ai * 128 + wr * 64 + m * 16 + fr;
                    f32x4 v0 = acc[ai][bj][m][0], v1 = acc[ai][bj][m][1];
                    if (rope) {
                        const int s = (row - NCTX) & 2047; const int pos = (wc & 1) ? (s & 63) : (s >> 6);
                        const f32x4 c0 = *(const f32x4*)(rcos + pos * 16 + ti), c1 = *(const f32x4*)(rcos + pos * 16 + ti + 4);
                        const f32x4 s0 = *(const f32x4*)(rsin + pos * 16 + ti), s1 = *(const f32x4*)(rsin + pos * 16 + ti + 4);
                        f32x4 p0, p1;
#pragma unroll
                        for (int e = 0; e < 4; ++e) {
                            const unsigned a0 = __builtin_bit_cast(unsigned, (float)v0[e]), a1 = __builtin_bit_cast(unsigned, (float)v1[e]);
                            auto r0 = __builtin_amdgcn_permlane32_swap(a0, a0, false, false); auto r1 = __builtin_amdgcn_permlane32_swap(a1, a1, false, false);
                            p0[e] = __builtin_bit_cast(float, fq < 2 ? r0[1] : r0[0]); p1[e] = __builtin_bit_cast(float, fq < 2 ? r1[1] : r1[0]); }
                        v0 = v0 * c0 + (p0 * s0) * sgn; v1 = v1 * c1 + (p1 * s1) * sgn;
                    }
                    if (colb < 512 || (colb >= 1536 && colb < 1792)) { v0 = v0 * QSCALE; v1 = v1 * QSCALE; }
                    if (silu) {
#pragma unroll
                        for (int e = 0; e < 4; ++e) { v0[e] = v0[e] / (1.f + __expf(-v0[e])); v1[e] = v1[e] / (1.f + __expf(-v1[e])); }
                    }
                    u32x4 w; w.x = cvt_pk_bf16(v0[0], v0[1]); w.y = cvt_pk_bf16(v0[2], v0[3]); w.z = cvt_pk_bf16(v1[0], v1[1]); w.w = cvt_pk_bf16(v1[2], v1[3]);
                    *(u32x4*)(dbase + (size_t)(ai * 128 + wr * 64 + m * 16 + fr) * dld) = w;
                    if (fo) { const int b = row >> 8, s = row & 255; float* dst = fo + (size_t)((b * 4 + layer) * 256 + s) * fld + fcol; *(f32x4*)dst = v0; *(f32x4*)(dst + 4) = v1; }
                    asm volatile("" ::: "memory");
                }
        }
    }
};
struct EpiDelta {
    static constexpr bool PERM = true, AFTER_DRAIN = false;
    unsigned char* ws; int layer;
    __device__ __forceinline__ void operator()(const f32x4 (&acc)[2][2][4][2], const Unit& u, int wr, int wc, int fr_, int fq_) const {
        int fr = fr_, fq = fq_; asm volatile("" : "+v"(fr), "+v"(fq));
        const bool ctx = u.pm < 32; const int p = ctx ? 0 : 1 + ((u.pm - 32) >> 3);
        const float* gate = (const float*)(ws + WS_MOD) + ((size_t)layer * 9 + p) * 3072 + 2048;
        bf16_t* D = (bf16_t*)(ws + WS_ACT);
        const int row0 = u.pm * 256 + wr * 64 + fr, col0 = u.pn * 256 + wc * 32 + 8 * fq;
        f32x4 gv[2][2];
#pragma unroll
        for (int bj = 0; bj < 2; ++bj)
#pragma unroll
            for (int n = 0; n < 2; ++n) gv[bj][n] = *(const f32x4*)(gate + col0 + bj * 128 + 4 * n);
#pragma unroll
        for (int ai = 0; ai < 2; ++ai)
#pragma unroll
            for (int m = 0; m < 4; ++m) { bf16_t* rowp = D + (size_t)(row0 + ai * 128 + m * 16) * DM + col0;
#pragma unroll
                for (int bj = 0; bj < 2; ++bj) { const f32x4 v0 = acc[ai][bj][m][0] * gv[bj][0], v1 = acc[ai][bj][m][1] * gv[bj][1];
                    u32x4 w; w.x = cvt_pk_bf16(v0[0], v0[1]); w.y = cvt_pk_bf16(v0[2], v0[3]); w.z = cvt_pk_bf16(v1[0], v1[1]); w.w = cvt_pk_bf16(v1[2], v1[3]);
                    *(u32x4*)(rowp + bj * 128) = w; } }
    }
};
template <class Epi, class Sched, bool ALIGN_EPI = false, bool SP2 = false>
__device__ __forceinline__ void gemm_phase(PG8_LAS unsigned char* lds, const Gemm g, const Sched& S, const Epi& E) {
    int tid_ = threadIdx.x; asm volatile("" : "+v"(tid_));
    const int tid = tid_, wid = __builtin_amdgcn_readfirstlane(tid >> 6), lane = tid & 63, wr = wid >> 2, wc = wid & 3, fr = lane & 15, fq = lane >> 4;
    const int K = g.K, nt = K / BK;
    unsigned voffA[2], voffB[2];
#pragma unroll
    for (int i = 0; i < 2; ++i) { int R, C; stage_rc(tid * 16 + i * 8192, R, C); const int Rb = Epi::PERM ? ((R & ~31) + perm32(R & 31)) : R;
        voffA[i] = (unsigned)(R * g.lda + C) * 2u; voffB[i] = (unsigned)(Rb * K + C) * 2u; }
    const size_t kstep = (size_t)(BK * 2);
    const size_t hstep = (size_t)HALF * K * 2;
    const size_t tstep = 2 * hstep;
    const size_t hstepA = (size_t)HALF * g.lda * 2, tstepA = 2 * hstepA;
    const unsigned ldsw = (unsigned)wid * 1024u;
    const int aoff = lds_byte(wr * 64 + fr, fq * 8), boff = lds_byte(wc * 32 + fr, fq * 8);
#define PG8_SA(b, h) (((b) * 2 + (h)) * HTB)
#define PG8_SB(b, h) ((4 + (b) * 2 + (h)) * HTB)
#define PG8_STAGE(bufoff, gbase, voff) do { _Pragma("unroll") for (int _i = 0; _i < 2; ++_i) \
        __builtin_amdgcn_global_load_lds((const unsigned*)((const char*)(gbase) + (voff)[_i]), (PG8_LAS unsigned*)(lds + (bufoff) + ldsw + _i * 8192), 16, 0, 0); } while (0)
#define PG8_LDA(dst, b, h) do { _Pragma("unroll") for (int m = 0; m < 4; ++m) _Pragma("unroll") for (int k = 0; k < 2; ++k) dst[m][k] = *(const PG8_LAS bf16x8*)(lds + PG8_SA(b, h) + aoff + m * 2048 + k * 1024); } while (0)
#define PG8_LDB(dst, b, h) do { _Pragma("unroll") for (int n = 0; n < 2; ++n) _Pragma("unroll") for (int k = 0; k < 2; ++k) dst[n][k] = *(const PG8_LAS bf16x8*)(lds + PG8_SB(b, h) + boff + n * 2048 + k * 1024); } while (0)
#define PG8_MMA(ai, bj, At, Bt) do { __builtin_amdgcn_s_setprio(1); _Pragma("unroll") for (int m = 0; m < 4; ++m) _Pragma("unroll") for (int n = 0; n < 2; ++n) _Pragma("unroll") for (int k = 0; k < 2; ++k) \
        acc[ai][bj][m][n] = __builtin_amdgcn_mfma_f32_16x16x32_bf16(Bt[n][k], At[m][k], acc[ai][bj][m][n], 0, 0, 0); __builtin_amdgcn_s_setprio(0); } while (0)
#define PG8_WAIT_V(n) asm volatile("s_waitcnt vmcnt(" #n ")" ::: "memory")
#define PG8_WAIT_L(n) asm volatile("s_waitcnt lgkmcnt(" #n ")" ::: "memory")
#define PG8_BAR __builtin_amdgcn_s_barrier()
#define PG8_SCHED __builtin_amdgcn_sched_barrier(0)
    Unit cur, nxt; int ui = 0;
    if (!S.next(0, cur)) return;
    f32x4 acc[2][2][4][2];
#pragma unroll
    for (int a = 0; a < 2; ++a)
#pragma unroll
        for (int b = 0; b < 2; ++b)
#pragma unroll
            for (int m = 0; m < 4; ++m)
#pragma unroll
                for (int n = 0; n < 2; ++n) acc[a][b][m][n] = (f32x4){0.f, 0.f, 0.f, 0.f};
    bf16x8 At[4][2], B0[2][2], B1[2][2];
    const char* cA = (const char*)g.A + (size_t)cur.pm * tstepA; const char* cB = (const char*)g.Bt + (size_t)cur.pn * tstep;
    S.a_ready(cur);
    if constexpr (SP2) {
        PG8_STAGE(PG8_SB(0, 0), cB, voffB); PG8_STAGE(PG8_SB(0, 1), cB + hstep, voffB); PG8_STAGE(PG8_SA(0, 0), cA, voffA); PG8_STAGE(PG8_SA(0, 1), cA + hstepA, voffA);
        if (wr == 1) PG8_BAR;
        PG8_WAIT_V(2); PG8_BAR;
        PG8_STAGE(PG8_SB(1, 0), cB + kstep, voffB); PG8_STAGE(PG8_SA(1, 0), cA + kstep, voffA); PG8_STAGE(PG8_SB(1, 1), cB + hstep + kstep, voffB);
        PG8_WAIT_V(6); PG8_BAR;
    } else {
        PG8_STAGE(PG8_SB(0, 0), cB, voffB); PG8_STAGE(PG8_SA(0, 0), cA, voffA); PG8_STAGE(PG8_SB(0, 1), cB + hstep, voffB); PG8_STAGE(PG8_SA(0, 1), cA + hstepA, voffA);
        if (wr == 1) PG8_BAR;
        PG8_WAIT_V(4); PG8_BAR;
        PG8_STAGE(PG8_SB(1, 0), cB + kstep, voffB); PG8_STAGE(PG8_SA(1, 0), cA + kstep, voffA); PG8_STAGE(PG8_SB(1, 1), cB + hstep + kstep, voffB);
        PG8_WAIT_V(6); PG8_BAR;
    }
    for (;;) {
        const bool has_next = S.next(ui + 1, nxt);
        const char* nA = has_next ? (const char*)g.A + (size_t)nxt.pm * tstepA : cA; const char* nB = has_next ? (const char*)g.Bt + (size_t)nxt.pn * tstep : cB;
        for (int t = 0; t < nt; t += 2) {
            const bool last = (t == nt - 2);
            const char* a1 = cA + (size_t)(t + 1) * kstep;
            const char* a2 = last ? nA : cA + (size_t)(t + 2) * kstep; const char* b2 = last ? nB : cB + (size_t)(t + 2) * kstep;
            const char* a3 = a2 + kstep; const char* b3 = b2 + kstep;
            if (last && has_next) S.a_ready(nxt);
            if constexpr (SP2) {
            PG8_LDB(B0, 0, 0); PG8_LDB(B1, 0, 1); PG8_SCHED; PG8_LDA(At, 0, 0); PG8_STAGE(PG8_SA(1, 1), a1 + hstepA, voffA);
            PG8_WAIT_V(8); PG8_WAIT_L(0); PG8_BAR; PG8_MMA(0, 0, At, B0); PG8_MMA(0, 1, At, B1); PG8_BAR; PG8_SCHED;
            PG8_LDA(At, 0, 1); PG8_STAGE(PG8_SB(0, 0), b2, voffB); PG8_STAGE(PG8_SB(0, 1), b2 + hstep, voffB); PG8_STAGE(PG8_SA(0, 0), a2, voffA);
            PG8_WAIT_V(8); PG8_WAIT_L(0); PG8_BAR; PG8_MMA(1, 0, At, B0); PG8_MMA(1, 1, At, B1); PG8_BAR; PG8_SCHED;
            PG8_LDB(B0, 1, 0); PG8_LDB(B1, 1, 1); PG8_SCHED; PG8_LDA(At, 1, 0); PG8_STAGE(PG8_SA(0, 1), a2 + hstepA, voffA);
            PG8_WAIT_V(8); PG8_WAIT_L(0); PG8_BAR; PG8_MMA(0, 0, At, B0); PG8_MMA(0, 1, At, B1); PG8_BAR; PG8_SCHED;
            PG8_LDA(At, 1, 1); PG8_STAGE(PG8_SB(1, 0), b3, voffB); PG8_STAGE(PG8_SB(1, 1), b3 + hstep, voffB); PG8_STAGE(PG8_SA(1, 0), a3, voffA);
            PG8_WAIT_V(8); PG8_WAIT_L(0); PG8_BAR; PG8_MMA(1, 0, At, B0); PG8_MMA(1, 1, At, B1); PG8_BAR; PG8_SCHED;
            } else {
            PG8_LDB(B0, 0, 0); PG8_SCHED; PG8_LDA(At, 0, 0); PG8_STAGE(PG8_SA(1, 1), a1 + hstepA, voffA);
            PG8_WAIT_L(8); PG8_BAR; PG8_WAIT_L(0); PG8_MMA(0, 0, At, B0); PG8_BAR; PG8_SCHED;
            PG8_LDB(B1, 0, 1); PG8_STAGE(PG8_SB(0, 0), b2, voffB);
            PG8_BAR; PG8_WAIT_L(0); PG8_MMA(0, 1, At, B1); PG8_BAR;
            PG8_LDA(At, 0, 1); PG8_STAGE(PG8_SA(0, 0), a2, voffA);
            PG8_BAR; PG8_WAIT_L(0); PG8_MMA(1, 0, At, B0); PG8_BAR; PG8_SCHED;
            PG8_STAGE(PG8_SB(0, 1), b2 + hstep, voffB);
            PG8_WAIT_V(6); PG8_BAR; PG8_MMA(1, 1, At, B1); PG8_BAR;
            PG8_LDB(B0, 1, 0); PG8_SCHED; PG8_LDA(At, 1, 0); PG8_STAGE(PG8_SA(0, 1), a2 + hstepA, voffA);
            PG8_WAIT_L(8); PG8_BAR; PG8_WAIT_L(0); PG8_MMA(0, 0, At, B0); PG8_BAR; PG8_SCHED;
            PG8_LDB(B1, 1, 1); PG8_STAGE(PG8_SB(1, 0), b3, voffB);
            PG8_BAR; PG8_WAIT_L(0); PG8_MMA(0, 1, At, B1); PG8_BAR;
            PG8_LDA(At, 1, 1); PG8_STAGE(PG8_SA(1, 0), a3, voffA);
            PG8_BAR; PG8_WAIT_L(0); PG8_MMA(1, 0, At, B0); PG8_BAR; PG8_SCHED;
            PG8_STAGE(PG8_SB(1, 1), b3 + hstep, voffB);
            PG8_WAIT_V(6); PG8_BAR; PG8_MMA(1, 1, At, B1); PG8_BAR;
            }
        }
        if constexpr (ALIGN_EPI) { if (wr == 0) PG8_BAR; }
        if constexpr (!Epi::AFTER_DRAIN) { E(acc, cur, wr, wc, fr, fq); S.done(cur); }
        if (!has_next) break;
#pragma unroll
        for (int a = 0; a < 2; ++a)
#pragma unroll
            for (int b = 0; b < 2; ++b)
#pragma unroll
                for (int m = 0; m < 4; ++m)
#pragma unroll
                    for (int n = 0; n < 2; ++n) acc[a][b][m][n] = (f32x4){0.f, 0.f, 0.f, 0.f};
        cur = nxt; cA = nA; cB = nB; ++ui;
        if constexpr (ALIGN_EPI) { if (wr == 1) PG8_BAR; }
    }
    PG8_WAIT_V(0);
    if constexpr (!ALIGN_EPI) { if (wr == 0) PG8_BAR; }
    PG8_BAR;
    if constexpr (Epi::AFTER_DRAIN) { E.fused(acc, cur, wr, wc, fr, fq, lds, wid, lane); S.done(cur); }
#undef PG8_SA
#undef PG8_SB
#undef PG8_STAGE
#undef PG8_LDA
#undef PG8_LDB
#undef PG8_MMA
#undef PG8_WAIT_V
#undef PG8_WAIT_L
#undef PG8_BAR
#undef PG8_SCHED
}
}
#define GAS __attribute__((address_space(1)))
#define LAS __attribute__((address_space(3)))
typedef unsigned short bf16;
typedef unsigned v4u __attribute__((ext_vector_type(4)));
typedef float f32x4 __attribute__((ext_vector_type(4)));
typedef short bf16x8 __attribute__((ext_vector_type(8)));
typedef GAS unsigned gu32;
typedef GAS unsigned long long gu64;
#define RLX_AGENT __ATOMIC_RELAXED, __HIP_MEMORY_SCOPE_AGENT
#define LDS_WAIT() asm volatile("s_waitcnt lgkmcnt(0)" ::: "memory")
#define VM_WAIT() asm volatile("s_waitcnt vmcnt(0)" ::: "memory")
__device__ __forceinline__ unsigned long long rt() { return __builtin_amdgcn_s_memrealtime(); }
__device__ __forceinline__ unsigned f2bf(float f) { unsigned u = __builtin_bit_cast(unsigned, f); return (u + 0x7fffu + ((u >> 16) & 1u)) >> 16; }
__device__ __forceinline__ unsigned pk2(float lo, float hi) { return f2bf(lo) | (f2bf(hi) << 16); }

#define XB_TMO      128
#define XB_XCNT(j)  (256  + 64 * (j))
#define XB_XSUB(j)  (1280 + 64 * (j))
#define XB_XGEN(j)  (2304 + 64 * (j))
#define XB_TOP      3328
#define XB_TOPGEN   3392
#define XCD_BAR_WORDS 3456
#define XB_SPIN_CAP (1u << 18)

__device__ __forceinline__ unsigned xb_ld(unsigned* p)              { return __hip_atomic_load(p, __ATOMIC_RELAXED, __HIP_MEMORY_SCOPE_AGENT); }
__device__ __forceinline__ unsigned xb_add(unsigned* p, unsigned v) { return __hip_atomic_fetch_add(p, v, __ATOMIC_RELAXED, __HIP_MEMORY_SCOPE_AGENT); }
__device__ __forceinline__ unsigned xb_xcc_id() { return (unsigned)__builtin_amdgcn_s_getreg((3 << 11) | 20) & 0xFu; }
#define XB_SPIN(cond, bar) do { unsigned _sp = 0; while (cond) { __builtin_amdgcn_s_sleep(1); \
    if ((++_sp & 255u) == 0u) { if (xb_ld(&(bar)[XB_TMO])) break; if (_sp > XB_SPIN_CAP) { atomicAdd(&(bar)[XB_TMO], 1u); break; } } } } while (0)

struct XcdBarrier {
    unsigned* bar; unsigned x;
    volatile LAS unsigned* st;
};

__device__ __forceinline__ XcdBarrier xcd_barrier_post(unsigned* bar, volatile LAS unsigned* st) {
    XcdBarrier b; b.bar = bar; b.x = xb_xcc_id(); b.st = st;
    if (threadIdx.x == 0) (void)xb_add(&bar[XB_XCNT(b.x)], 1u);
    return b;
}
__device__ __forceinline__ void xcd_barrier_complete(unsigned* bar, unsigned x, unsigned& nloc, unsigned& nx) {
    const unsigned G = gridDim.x * gridDim.y * gridDim.z;
    unsigned sum, cnt, mine, sp = 0u;
    for (;;) {
        sum = 0u; cnt = 0u; mine = 0u;
#pragma unroll
        for (unsigned j = 0; j < 16; ++j) { const unsigned c = xb_ld(&bar[XB_XCNT(j)]); sum += c; cnt += (c > 0u) ? 1u : 0u; mine = (j == x) ? c : mine; }
        if (sum == G) break;
        __builtin_amdgcn_s_sleep(1);
        if ((++sp & 255u) == 0u) { if (xb_ld(&bar[XB_TMO])) break; if (sp > XB_SPIN_CAP) { atomicAdd(&bar[XB_TMO], 1u); break; } }
    }
    nloc = mine > 0u ? mine : 1u; nx = cnt > 0u ? cnt : 1u;
}

__device__ __forceinline__ void xcd_barrier(const XcdBarrier& b) {
    asm volatile("s_waitcnt vmcnt(0)" ::: "memory");
    __syncthreads();
    if (threadIdx.x == 0) {
        unsigned* bar = b.bar;
        __builtin_amdgcn_s_waitcnt(0);
        unsigned nloc = b.st[0], nx = b.st[1];
        if (nloc == 0u) { xcd_barrier_complete(bar, b.x, nloc, nx); b.st[0] = nloc; b.st[1] = nx; }
        const unsigned old = xb_add(&bar[XB_XSUB(b.x)], 1u);
        const unsigned gen = old / nloc;
        if (old + 1u == (gen + 1u) * nloc) {
            __builtin_amdgcn_fence(__ATOMIC_RELEASE, "agent");
            asm volatile("s_waitcnt vmcnt(0)" ::: "memory");
            const unsigned og = xb_add(&bar[XB_TOP], 1u);
            const unsigned tg = og / nx;
            if (og + 1u == (tg + 1u) * nx) xb_add(&bar[XB_TOPGEN], 1u);
            else XB_SPIN(xb_ld(&bar[XB_TOPGEN]) == tg, bar);
            __builtin_amdgcn_fence(__ATOMIC_ACQUIRE, "agent");
            xb_add(&bar[XB_XGEN(b.x)], 1u);
            asm volatile("s_waitcnt vmcnt(0)" ::: "memory");
        } else {
            XB_SPIN(xb_ld(&bar[XB_XGEN(b.x)]) == gen, bar);
            __builtin_amdgcn_fence(__ATOMIC_ACQUIRE, "agent");
            asm volatile("s_waitcnt vmcnt(0)" ::: "memory");
        }
    }
    __syncthreads();
}

struct Frame {
    LAS unsigned char* lds;
    int tid, lane, wave, G;
    float* out;
    unsigned char* ws;
    __device__ __forceinline__ float* MOD() const { return (float*)(ws + WS_MOD); }
    __device__ __forceinline__ float* GF() const { return (float*)(ws + WS_G); }
    __device__ __forceinline__ float* ROPE() const { return (float*)(ws + WS_ROPE); }
    __device__ __forceinline__ bf16* DFTC() const { return (bf16*)(ws + WS_DFTC); }
    __device__ __forceinline__ bf16* FM1() const { return (bf16*)(ws + WS_FM1); }
    __device__ __forceinline__ bf16* FM2() const { return (bf16*)(ws + WS_FM2); }
    __device__ __forceinline__ float* FT2() const { return (float*)(ws + WS_FT2); }
    __device__ __forceinline__ bf16* WIN(int) const { return (bf16*)(ws + WS_WIN); }
    __device__ __forceinline__ bf16* WOUT(int l) const { return (bf16*)(ws + WS_WOUT + (size_t)(l & 1) * WOUT_BYTES); }
    __device__ __forceinline__ float* GS() const { return (float*)(ws + WS_GS); }
    __device__ __forceinline__ float* BIAS() const { return (float*)(ws + WS_BIAS); }
    __device__ __forceinline__ float* ROWSS() const { return (float*)(ws + WS_ROWSS); }
    __device__ __forceinline__ bf16* ACT() const { return (bf16*)(ws + WS_ACT); }
    __device__ __forceinline__ bf16* PROJ() const { return (bf16*)(ws + WS_PROJ); }
};
__device__ __forceinline__ float wave_sum(float v) {
#pragma unroll
    for (int o = 1; o < 64; o <<= 1) v += __shfl_xor(v, o);
    return v;
}
__device__ __forceinline__ float bf2f(unsigned short h) { return __builtin_bit_cast(float, (unsigned)h << 16); }
__device__ __forceinline__ float silu_f(float v) { return v / (1.f + __expf(-v)); }

__device__ __forceinline__ void p0_transpose_item(const float* W, int K, int N, bf16* WT, int row_off, LAS float* scr, int item, int lane) {
    const int nblk = N / 32, kb = item / nblk, nb = item % nblk, k0 = 64 * kb, n0 = 32 * nb;
    float wl[32];
#pragma unroll
    for (int i = 0; i < 32; ++i) { const int kk = 2 * i + (lane >> 5); wl[i] = W[(size_t)(k0 + kk) * N + n0 + (lane & 31)]; }
#pragma unroll
    for (int i = 0; i < 32; ++i) { const int kk = 2 * i + (lane >> 5); scr[kk * 33 + (lane & 31)] = wl[i]; }
    LDS_WAIT(); asm volatile("" ::: "memory");
    const int c = lane & 7;
#pragma unroll
    for (int j = 0; j < 4; ++j) { const int n = (lane >> 3) + 8 * j; const LAS float* s = scr + (8 * c) * 33 + n;
        v4u o; o.x = pk2(s[0 * 33], s[1 * 33]); o.y = pk2(s[2 * 33], s[3 * 33]); o.z = pk2(s[4 * 33], s[5 * 33]); o.w = pk2(s[6 * 33], s[7 * 33]);
        *(GAS v4u*)(WT + (size_t)(row_off + n0 + n) * K + k0 + 8 * c) = o; }
    LDS_WAIT(); asm volatile("" ::: "memory");
}
__device__ __forceinline__ void fold_item(const float* win_l, const float* G_l, bf16* WinT, LAS float* scr, int item, int lane) {
    const int kb = item >> 6, g = (item >> 4) & 3, nb = item & 15;
    const int k = kb * 64 + lane;
    const f32x4* src = (const f32x4*)(win_l + (size_t)k * NIN + 2048 + g * 64);
    const float* Gg = G_l + g * 64 * 128 + nb * 8;
    f32x4 wv[16];
#pragma unroll
    for (int i = 0; i < 16; ++i) wv[i] = src[i];
    { const f32x4 g0 = *(const f32x4*)(Gg + lane * 128), g1 = *(const f32x4*)(Gg + lane * 128 + 4);
      *(LAS f32x4*)(scr + lane * 8) = g0; *(LAS f32x4*)(scr + lane * 8 + 4) = g1; }
    LDS_WAIT(); asm volatile("" ::: "memory");
    float a[8];
#pragma unroll
    for (int nn = 0; nn < 8; ++nn) a[nn] = 0.f;
#pragma unroll
    for (int i = 0; i < 16; ++i)
#pragma unroll
        for (int e = 0; e < 4; ++e) { const float w = wv[i][e]; const int c = 4 * i + e;
            const f32x4 g0 = *(const LAS f32x4*)(scr + c * 8), g1 = *(const LAS f32x4*)(scr + c * 8 + 4);
            a[0] += w * g0.x; a[1] += w * g0.y; a[2] += w * g0.z; a[3] += w * g0.w; a[4] += w * g1.x; a[5] += w * g1.y; a[6] += w * g1.z; a[7] += w * g1.w; }
    LDS_WAIT(); asm volatile("" ::: "memory");
#pragma unroll
    for (int nn = 0; nn < 8; ++nn) { const int n2 = nb * 8 + nn; const int ri = n2 >> 6, d = n2 & 63; const int nrow = 2048 + ri * 256 + g * 64 + d;
        WinT[(size_t)nrow * 1024 + k] = (bf16)f2bf(a[nn]); }
}
template <bool FINAL, int NR>
__device__ __forceinline__ void stream_row(const float* const (&xprev)[NR], const bf16* const (&drow)[NR], float* const (&xw)[NR], bf16* const (&hn)[NR], float* const (&yrow)[NR],
                                           const float* g, const float* const (&scale)[NR], const float* const (&shift)[NR], int lane) {
    f32x4 v[NR][4]; unsigned long long dd[NR][4]; float s[NR];
#pragma unroll
    for (int r = 0; r < NR; ++r) if (xprev[r]) {
#pragma unroll
        for (int j = 0; j < 4; ++j) v[r][j] = ((const GAS f32x4*)xprev[r] + lane)[64 * j];
        if (drow[r]) {
#pragma unroll
            for (int j = 0; j < 4; ++j) dd[r][j] = *(const GAS unsigned long long*)(drow[r] + 4 * (lane + 64 * j)); }
    }
#pragma unroll
    for (int r = 0; r < NR; ++r) if (xprev[r]) {
        if (drow[r]) {
#pragma unroll
            for (int j = 0; j < 4; ++j) { const unsigned long long d = dd[r][j];
                v[r][j].x += bf2f((unsigned short)d); v[r][j].y += bf2f((unsigned short)(d >> 16)); v[r][j].z += bf2f((unsigned short)(d >> 32)); v[r][j].w += bf2f((unsigned short)(d >> 48)); }
        }
        float t = 0.f;
#pragma unroll
        for (int j = 0; j < 4; ++j) t += (v[r][j].x * v[r][j].x + v[r][j].y * v[r][j].y) + (v[r][j].z * v[r][j].z + v[r][j].w * v[r][j].w);
        s[r] = t;
    }
    f32x4 gv[4], scv[NR][4], shv[NR][4];
#pragma unroll
    for (int j = 0; j < 4; ++j) { const int k = 4 * (lane + 64 * j); gv[j] = *(const f32x4*)(g + k);
        if (!FINAL) {
#pragma unroll
            for (int r = 0; r < NR; ++r) { scv[r][j] = *(const f32x4*)(scale[r] + k); shv[r][j] = *(const f32x4*)(shift[r] + k); } } }
    float rstd[NR];
#pragma unroll
    for (int r = 0; r < NR; ++r) rstd[r] = xprev[r] ? 1.f / sqrtf(wave_sum(s[r]) * (1.f / DM) + RMS_EPS) : 0.f;
#pragma unroll
    for (int r = 0; r < NR; ++r) if (xprev[r]) {
        if (xw[r]) {
#pragma unroll
            for (int j = 0; j < 4; ++j) *((GAS f32x4*)xw[r] + lane + 64 * j) = v[r][j];
        }
#pragma unroll
        for (int j = 0; j < 4; ++j) {
            const int k = 4 * (lane + 64 * j);
            if (FINAL) { *(f32x4*)(yrow[r] + k) = v[r][j] * rstd[r] * gv[j]; }
            else {
                const f32x4 h = (v[r][j] * rstd[r]) * (gv[j] * (scv[r][j] + 1.f)) + shv[r][j];
                *(GAS unsigned long long*)(hn[r] + k) = (unsigned long long)pk2(h.x, h.y) | ((unsigned long long)pk2(h.z, h.w) << 32);
            }
        }
    }
}

namespace att {
using bf16x8 = __attribute__((ext_vector_type(8))) short;
using s16x4 = __attribute__((ext_vector_type(4))) short;
using f32x16 = __attribute__((ext_vector_type(16))) float;
using u32x4 = __attribute__((ext_vector_type(4))) unsigned;
constexpr int QBLK = 32, KVBLK = 64;
constexpr float SCALE = 0.125f;
constexpr float THR = 8.f;
constexpr int SHM_V = 64 * 128 * 2, SHM_K = 64 * 128 * 2;
#define KSWZ(row, colB) ((row) * 256 + ((colB) ^ (((row) & 7) << 4)))
#define SBAR() __builtin_amdgcn_sched_barrier(0)
__device__ __forceinline__ int crow(int r, int hi) { return (r & 3) + 8 * (r >> 2) + 4 * hi; }
__device__ __forceinline__ unsigned cvtpk(float lo, float hi) { unsigned r; asm volatile("v_cvt_pk_bf16_f32 %0, %1, %2" : "=v"(r) : "v"(lo), "v"(hi)); return r; }
__device__ __forceinline__ bf16x8 ld8(const bf16* p) { return *reinterpret_cast<const bf16x8*>(p); }

constexpr float THRL = 11.5f;
__device__ __forceinline__ void partialSM(f32x16& p0, f32x16& p1, float& mhat, f32x16& negm, float& alpha) {
  float pmax = p0[0];
#pragma unroll
  for (int r = 1; r < 16; ++r) pmax = fmaxf(pmax, p0[r]);
#pragma unroll
  for (int r = 0; r < 16; ++r) pmax = fmaxf(pmax, p1[r]);
  { auto rr = __builtin_amdgcn_permlane32_swap(__float_as_uint(pmax), __float_as_uint(pmax), false, false);
    pmax = fmaxf(__uint_as_float(rr[0]), __uint_as_float(rr[1])); }
  if (__builtin_expect(__all(pmax <= THRL), 1)) { alpha = 1.f; }
  else { const float dl = fmaxf(pmax, 0.f); mhat += dl; alpha = __builtin_amdgcn_exp2f(-dl);
#pragma unroll
    for (int r = 0; r < 16; ++r) { p0[r] -= dl; p1[r] -= dl; negm[r] = -mhat; } }
#pragma unroll
  for (int r = 0; r < 16; ++r) p0[r] = __builtin_amdgcn_exp2f(p0[r]);
}
__device__ __forceinline__ void finishSM(f32x16& p0, f32x16& p1, float alpha, float& l_reg, bf16x8& pa0, bf16x8& pa1, bf16x8& pa2, bf16x8& pa3) {
#pragma unroll
  for (int r = 0; r < 16; ++r) p1[r] = __builtin_amdgcn_exp2f(p1[r]);
  float ps = 0;
#pragma unroll
  for (int r = 0; r < 16; ++r) ps += p0[r];
#pragma unroll
  for (int r = 0; r < 16; ++r) ps += p1[r];
  { auto rr = __builtin_amdgcn_permlane32_swap(__float_as_uint(ps), __float_as_uint(ps), false, false);
    ps = __uint_as_float(rr[0]) + __uint_as_float(rr[1]); }
  l_reg = l_reg * alpha + ps;
#define PK4(P, BASE, OUT) do { unsigned a0 = cvtpk(P[BASE + 0], P[BASE + 1]), a1 = cvtpk(P[BASE + 2], P[BASE + 3]);   \
    unsigned b0 = cvtpk(P[BASE + 4], P[BASE + 5]), b1 = cvtpk(P[BASE + 6], P[BASE + 7]);                              \
    auto r0 = __builtin_amdgcn_permlane32_swap(a0, b0, false, false); auto r1 = __builtin_amdgcn_permlane32_swap(a1, b1, false, false); \
    u32x4 w = {r0[0], r1[0], r0[1], r1[1]}; OUT = *reinterpret_cast<bf16x8*>(&w); } while (0)
  PK4(p0, 0, pa0); PK4(p0, 8, pa1); PK4(p1, 0, pa2); PK4(p1, 8, pa3);
#undef PK4
}
template <int KP> __device__ __forceinline__ void qkt(f32x16& p0, f32x16& p1, const char* Ks, const bf16x8* qr, int r32, int hi, int kcb, const f32x16& negm) {
  p0 = negm; p1 = negm;
#pragma unroll
  for (int d0 = 0; d0 < 4; ++d0) { int cb = kcb + (d0 * 16 + hi * 8) * 2;
    bf16x8 b0 = *reinterpret_cast<const bf16x8*>(Ks + r32 * KP + (cb ^ ((r32 & 7) << 4)));
    bf16x8 b1 = *reinterpret_cast<const bf16x8*>(Ks + (32 + r32) * KP + (cb ^ ((r32 & 7) << 4)));
    p0 = __builtin_amdgcn_mfma_f32_32x32x16_bf16(b0, qr[d0], p0, 0, 0, 0);
    p1 = __builtin_amdgcn_mfma_f32_32x32x16_bf16(b1, qr[d0], p1, 0, 0, 0); }
}
__device__ __forceinline__ int v_st(int k, int c) { const int kk = (k & ~0xC) | ((k & 4) << 1) | ((k & 8) >> 1); return ((kk >> 3) * 4 + (c >> 5)) * 512 + ((kk & 7) * 32 + (c & 31)) * 2; }
__device__ __forceinline__ int v_rd_base(int lane) { return ((lane & 3) << 3) | (((lane >> 2) & 3) << 6) | (((lane >> 4) & 1) << 5) | (((lane >> 5) & 1) << 8); }
constexpr int v_rd_off(int d0, int ks, int half, bool w64 = false) { return w64 ? d0 * 512 + ks * 2048 + half * 1024 : d0 * 512 + ks * 4096 + half * 2048; }
template <int OFF> __device__ __forceinline__ s16x4 tr_read(int vb) {
  s16x4 r; asm volatile("ds_read_b64_tr_b16 %0, %1 offset:%2" : "=&v"(r) : "v"(vb), "i"(OFF) : "memory"); return r;
}
template <int D0, bool W64 = false> __device__ __forceinline__ void pv_one(f32x16& od, int vb, bf16x8 pa0, bf16x8 pa1, bf16x8 pa2, bf16x8 pa3) {
  const s16x4 l0 = tr_read<v_rd_off(D0, 0, 0, W64)>(vb), h0 = tr_read<v_rd_off(D0, 0, 1, W64)>(vb), l1 = tr_read<v_rd_off(D0, 1, 0, W64)>(vb), h1 = tr_read<v_rd_off(D0, 1, 1, W64)>(vb);
  const s16x4 l2 = tr_read<v_rd_off(D0, 2, 0, W64)>(vb), h2 = tr_read<v_rd_off(D0, 2, 1, W64)>(vb), l3 = tr_read<v_rd_off(D0, 3, 0, W64)>(vb), h3 = tr_read<v_rd_off(D0, 3, 1, W64)>(vb);
  asm volatile("s_waitcnt lgkmcnt(0)" ::: "memory"); SBAR();
#define PK(L, H) (bf16x8){L[0], L[1], L[2], L[3], H[0], H[1], H[2], H[3]}
  od = __builtin_amdgcn_mfma_f32_32x32x16_bf16(pa0, PK(l0, h0), od, 0, 0, 0);
  od = __builtin_amdgcn_mfma_f32_32x32x16_bf16(pa1, PK(l1, h1), od, 0, 0, 0);
  od = __builtin_amdgcn_mfma_f32_32x32x16_bf16(pa2, PK(l2, h2), od, 0, 0, 0);
  od = __builtin_amdgcn_mfma_f32_32x32x16_bf16(pa3, PK(l3, h3), od, 0, 0, 0);
#undef PK
}
template <int ND> __device__ __forceinline__ void pv_all(f32x16* o, int vb, bf16x8 pa0, bf16x8 pa1, bf16x8 pa2, bf16x8 pa3) {
  if constexpr (ND == 4) { pv_one<0>(o[0], vb, pa0, pa1, pa2, pa3); pv_one<1>(o[1], vb, pa0, pa1, pa2, pa3); pv_one<2>(o[2], vb, pa0, pa1, pa2, pa3); pv_one<3>(o[3], vb, pa0, pa1, pa2, pa3); }
  else { pv_one<0, true>(o[0], vb, pa0, pa1, pa2, pa3); pv_one<1, true>(o[1], vb, pa0, pa1, pa2, pa3); }
}
__device__ __forceinline__ void glds16(const void* gsrc, unsigned lds_dst) { unsigned keep;
  asm volatile("s_mov_b32 %0, m0\n\ts_mov_b32 m0, %2\n\ts_nop 0\n\tglobal_load_lds_dwordx4 %1, off\n\ts_mov_b32 m0, %0" : "=&s"(keep) : "v"(gsrc), "s"(lds_dst) : "memory"); }
struct TileSrc { const bf16* k; const bf16* v; int kpos0; };
template <int MODE> __device__ __forceinline__ TileSrc tile_src(const Frame& F, int path, int b, int hh, int qb, int j) {
  TileSrc t; t.kpos0 = -1;
  if (MODE == 0) {
    const size_t off = (path ? (size_t)(b * 4 + hh) * 2304 : (size_t)(b * 4 + hh) * 256) * 128 + (size_t)j * 64 * 128;
    t.k = (const bf16*)(F.ws + (path ? WS_KAL : WS_KAC)) + off; t.v = (const bf16*)(F.ws + (path ? WS_VAL : WS_VAC)) + off;
  } else {
    int kt = j;
    if (path) { const int nloc = 2 + (qb > 0 ? 2 : 0) + (qb < 15 ? 2 : 0);
      if (j < nloc) { if (j < 2) kt = 2 * qb + j; else if (qb > 0 && j < 4) kt = 2 * qb - 2 + (j - 2); else kt = 2 * qb + 2 + (j - (qb > 0 ? 4 : 2)); t.kpos0 = kt * 64; }
      else kt = 32 + (j - nloc); }
    const size_t off = (path ? (size_t)(b * 2 + hh) * 2304 : (size_t)(b * 2 + hh) * 256) * 64 + (size_t)kt * 64 * 64;
    t.k = (const bf16*)(F.ws + (path ? WS_KBL : WS_KBC)) + off; t.v = (const bf16*)(F.ws + (path ? WS_VBL : WS_VBC)) + off;
  }
  return t;
}
template <int MODE> struct Stg;
template <> struct Stg<0> { bf16x8 vs0, vs1, ks0, ks1; };
template <> struct Stg<1> { bf16x8 vs0, ks0; };

template <int MODE>
__device__ __forceinline__ void attn_unit(const Frame& F, int layer, int path, int b, int hh, int qb, char* lds) {
  constexpr int ND = MODE == 0 ? 4 : 2;
  int tid_ = threadIdx.x; asm volatile("" : "+v"(tid_));
  const int tid = tid_, wid = __builtin_amdgcn_readfirstlane(tid >> 6), lane = tid & 63, r32 = lane & 31, hi = lane >> 5;
  const int wq = wid & 3, wc = wid >> 2;
  constexpr int VB = MODE == 0 ? 16384 : 8192, SLOT = 2 * VB;
  constexpr int KP = MODE == 0 ? 256 : 128;
  constexpr int NP = MODE == 0 ? 2 : 1, NDMA = 2 * NP;
  float* ws = (float*)(lds + 131072 + 1024) + wid * 64; float* li_l = ws; float* al_l = ws + 32;
  const long rowbase = path ? NCTX + (long)b * 2048 : (long)b * 256;
  const long qrow0 = rowbase + qb * 128 + wq * 32;
  const int qcol = MODE == 0 ? C_QA + hh * 128 + wc * 64 : C_QB + (hh * 2 + wc) * 64;
  const int kcb = MODE == 0 ? wc * 128 : 0;
  const int NT = MODE == 0 ? (path ? 36 : 4) : (path ? 6 + (qb > 0 ? 2 : 0) + (qb < 15 ? 2 : 0) : 4);
  const int qpos = qb * 128 + wq * 32 + r32;
  float mhat = 0.f, l_reg = 0; f32x16 o[ND]; bf16x8 qr[4]; f32x16 negm = f32x16{};
#pragma unroll
  for (int d = 0; d < ND; ++d) o[d] = f32x16{};
  const unsigned lds0 = (unsigned)(uintptr_t)lds;
  const int vb0 = (int)lds0 + v_rd_base(lane);
  int ksrc[NP], vsrc[NP];
#pragma unroll
  for (int i = 0; i < NP; ++i) { const int o_ = (wid * NP + i) * 1024 + lane * 16;
    if (MODE == 0) { const int r = o_ >> 8, c_ = (o_ >> 4) & 15; ksrc[i] = r * 256 + ((c_ ^ (r & 7)) << 4);
      const int st = o_ >> 9, w_ = o_ & 511, kk = (st >> 2) * 8 + (w_ >> 6), k = (kk & ~0xC) | ((kk & 4) << 1) | ((kk & 8) >> 1), c = (st & 3) * 32 + ((w_ & 63) >> 1); vsrc[i] = k * 256 + c * 2; }
    else { const int r = o_ >> 7, c_ = (o_ >> 4) & 7; ksrc[i] = r * 128 + ((c_ ^ (r & 7)) << 4);
      const int st = o_ >> 9, w_ = o_ & 511, kk = (st >> 1) * 8 + (w_ >> 6), k = (kk & ~0xC) | ((kk & 4) << 1) | ((kk & 8) >> 1), c = (st & 1) * 32 + ((w_ & 63) >> 1); vsrc[i] = k * 128 + c * 2; } }
#define DMA_TILE(j_, so) do { const TileSrc ts_ = tile_src<MODE>(F, path, b, hh, qb, (j_)); \
    _Pragma("unroll") for (int i = 0; i < NP; ++i) { const unsigned d_ = lds0 + (unsigned)(so) + (unsigned)((wid * NP + i) * 1024); \
      glds16((const char*)ts_.v + vsrc[i], (unsigned)__builtin_amdgcn_readfirstlane(d_)); glds16((const char*)ts_.k + ksrc[i], (unsigned)__builtin_amdgcn_readfirstlane(d_ + VB)); } } while (0)
#define DMA_WAIT(n) do { if ((n) == 0) asm volatile("s_waitcnt vmcnt(0)" ::: "memory"); else if (NDMA == 4) asm volatile("s_waitcnt vmcnt(4)" ::: "memory"); else asm volatile("s_waitcnt vmcnt(2)" ::: "memory"); } while (0)
#define RESC(a) do { if (__any((a) < 1.f)) { if (hi == 0) al_l[r32] = (a); asm volatile("s_waitcnt lgkmcnt(0)" ::: "memory"); \
    _Pragma("unroll") for (int d = 0; d < ND; ++d) _Pragma("unroll") for (int r = 0; r < 16; ++r) o[d][r] *= al_l[crow(r, hi)]; } } while (0)
#define MASK(P0, P1, j_) do { if (MODE == 1 && path == 1 && (j_) >= 2) { const TileSrc tm_ = tile_src<MODE>(F, path, b, hh, qb, (j_)); if (tm_.kpos0 >= 0) { \
    const unsigned db_ = (unsigned)(tm_.kpos0 - qpos + 4 * hi + 128);     \
    _Pragma("unroll") for (int r = 0; r < 16; ++r) { const unsigned c_ = (unsigned)((r & 3) + 8 * (r >> 2)); \
      if (db_ + c_ > 256u) P0[r] = -__builtin_inff(); if (db_ + c_ + 32u > 256u) P1[r] = -__builtin_inff(); } } } } while (0)
  f32x16 pA0, pA1, pB0, pB1; float alA, alB; bf16x8 pa0, pa1, pa2, pa3;
  int s_prev = 0, s_cur = SLOT, s_dma = 3 * SLOT;
#define ROT() do { s_prev = s_cur; s_cur = (s_cur + SLOT) & (4 * SLOT - 1); s_dma = (s_dma + SLOT) & (4 * SLOT - 1); } while (0)
#define STEP(PC0, PC1, ALC, PP0, PP1, ALP, j_) do { const bool more_ = (j_) + 2 < NT; if (more_) DMA_TILE((j_) + 2, s_dma); \
    SBAR(); qkt<KP>(PC0, PC1, lds + s_cur + VB, qr, r32, hi, kcb, negm); \
    finishSM(PP0, PP1, ALP, l_reg, pa0, pa1, pa2, pa3); SBAR(); \
    pv_all<ND>(o, vb0 + s_prev, pa0, pa1, pa2, pa3); MASK(PC0, PC1, (j_)); partialSM(PC0, PC1, mhat, negm, ALC); \
    RESC(ALC); if (more_) DMA_WAIT(1); else DMA_WAIT(0); __syncthreads(); ROT(); } while (0)
  DMA_TILE(0, 0); DMA_TILE(1, SLOT); DMA_TILE(2, 2 * SLOT);
  { const bf16* Qw = F.PROJ() + (qrow0 + r32) * LDP + qcol + hi * 8;
#pragma unroll
    for (int d0 = 0; d0 < 4; ++d0) qr[d0] = ld8(Qw + d0 * 16); }
  DMA_WAIT(1); __syncthreads();
  qkt<KP>(pA0, pA1, lds + VB, qr, r32, hi, kcb, negm); MASK(pA0, pA1, 0); partialSM(pA0, pA1, mhat, negm, alA);
  for (int j = 1; j + 1 < NT; j += 2) {
    STEP(pB0, pB1, alB, pA0, pA1, alA, j);
    STEP(pA0, pA1, alA, pB0, pB1, alB, j + 1);
  }
  SBAR(); qkt<KP>(pB0, pB1, lds + s_cur + VB, qr, r32, hi, kcb, negm);
  finishSM(pA0, pA1, alA, l_reg, pa0, pa1, pa2, pa3); SBAR();
  pv_all<ND>(o, vb0 + s_prev, pa0, pa1, pa2, pa3); MASK(pB0, pB1, NT - 1); partialSM(pB0, pB1, mhat, negm, alB);
  RESC(alB);
  finishSM(pB0, pB1, alB, l_reg, pa0, pa1, pa2, pa3); SBAR();
  pv_all<ND>(o, vb0 + s_cur, pa0, pa1, pa2, pa3);
#undef STEP
#undef ROT
#undef DMA_TILE
#undef DMA_WAIT
#undef RESC
#undef MASK
  if (MODE == 1) { const float sk = in_ptr(17)[layer * 4 + hh * 2 + wc]; l_reg += __builtin_amdgcn_exp2f(sk * 1.4426950408889634f - mhat); }
  if (hi == 0) li_l[r32] = l_reg; asm volatile("s_waitcnt lgkmcnt(0)" ::: "memory");
  float rli[16];
#pragma unroll
  for (int r = 0; r < 16; ++r) rli[r] = __builtin_amdgcn_rcpf(li_l[crow(r, hi)]);
  if (MODE == 0) {
    const float lam = F.ROPE()[2048 + layer * 2], omli = F.ROPE()[2048 + layer * 2 + 1];
    float* X = (float*)lds;
    __syncthreads();
    if (wc == 1) {
#pragma unroll
      for (int d = 0; d < 4; ++d)
#pragma unroll
        for (int r = 0; r < 16; ++r) X[((wq * 4 + d) * 16 + r) * 64 + lane] = o[d][r] * rli[r] * lam;
    }
    __syncthreads();
    if (wc == 0) {
      const float* dg = in_ptr(16) + layer * 128;
      float dgv[4];
#pragma unroll
      for (int d = 0; d < 4; ++d) dgv[d] = dg[32 * d + r32] * omli;
      unsigned short zv[16][4];
#pragma unroll
      for (int r = 0; r < 16; ++r) { const bf16* zr = F.PROJ() + (qrow0 + crow(r, hi)) * LDP + C_Z + hh * 128 + r32;
#pragma unroll
        for (int d = 0; d < 4; ++d) zv[r][d] = zr[32 * d]; }
#pragma unroll
      for (int r = 0; r < 16; ++r) {
        float v[4]; float ss = 0.f;
#pragma unroll
        for (int d = 0; d < 4; ++d) { v[d] = o[d][r] * rli[r] - X[((wq * 4 + d) * 16 + r) * 64 + lane]; ss += v[d] * v[d]; }
#pragma unroll
        for (int off = 1; off < 32; off <<= 1) ss += __shfl_xor(ss, off);
        const float rstd = 1.f / sqrtf(ss * (1.f / 128.f) + RMS_EPS);
        bf16* mr = F.PROJ() + (qrow0 + crow(r, hi)) * LDP + C_Z + hh * 128 + r32;
#pragma unroll
        for (int d = 0; d < 4; ++d) mr[32 * d] = (bf16)f2bf(v[d] * rstd * dgv[d] * bf2f(zv[r][d]));
      }
    }
    __syncthreads();
  } else {
    const int mc = 512 + (hh * 2 + wc) * 64 + r32;
    unsigned short zv[16][2];
#pragma unroll
    for (int r = 0; r < 16; ++r) { const bf16* zr = F.PROJ() + (qrow0 + crow(r, hi)) * LDP + C_Z + mc; zv[r][0] = zr[0]; zv[r][1] = zr[32]; }
#pragma unroll
    for (int r = 0; r < 16; ++r) {
      bf16* mr = F.PROJ() + (qrow0 + crow(r, hi)) * LDP + C_Z + mc;
#pragma unroll
      for (int d = 0; d < 2; ++d) mr[32 * d] = (bf16)f2bf(o[d][r] * rli[r] * bf2f(zv[r][d]));
    }
    __syncthreads();
  }
}

__device__ __forceinline__ void fourier_unit(const Frame& F, int path, int b, int kb, int cb, char* lds) {
  int tid_ = threadIdx.x; asm volatile("" : "+v"(tid_));
  const int tid = tid_, wid = __builtin_amdgcn_readfirstlane(tid >> 6), lane = tid & 63, r32 = lane & 31, hi = lane >> 5;
  char* V_lds = lds;
  const int S = path ? 2048 : 256, TPP = S / 64, NT = 2 * TPP;
  const long rowbase = path ? NCTX + (long)b * 2048 : (long)b * 256;
  const int k0 = kb * 256 + wid * 32;
  const bf16* Dm = F.DFTC() + (long)(k0 + r32) * (2 * S) + hi * 8;
  const int sr = tid >> 3, sc = (tid & 7) * 8;
  const int vst0 = v_st(sr, sc);
  const int vb0 = (int)(uintptr_t)V_lds + v_rd_base(lane);
  f32x16 o[2]; o[0] = f32x16{}; o[1] = f32x16{};
  bf16x8 a0, a1, a2, a3, n0, n1, n2, n3, vreg;
#define FV_SRC(j_) (F.PROJ() + (rowbase + ((j_) % TPP) * 64 + sr) * LDP + C_VF + ((j_) / TPP) * 256 + cb * 64 + sc)
#define FA_LOAD(A0, A1, A2, A3, j_) do { const bf16* p_ = Dm + ((j_) / TPP) * S + ((j_) % TPP) * 64; A0 = ld8(p_); A1 = ld8(p_ + 16); A2 = ld8(p_ + 32); A3 = ld8(p_ + 48); } while (0)
  vreg = ld8(FV_SRC(0)); FA_LOAD(a0, a1, a2, a3, 0);
  *(bf16x8*)(V_lds + vst0) = vreg; __syncthreads();
  for (int j = 0; j < NT; ++j) {
    const bool more = j + 1 < NT;
    if (more) { vreg = ld8(FV_SRC(j + 1)); FA_LOAD(n0, n1, n2, n3, j + 1); }
    pv_one<0>(o[0], vb0 + (j & 1) * SHM_V, a0, a1, a2, a3); pv_one<1>(o[1], vb0 + (j & 1) * SHM_V, a0, a1, a2, a3);
    if (more) { *(bf16x8*)(V_lds + ((j + 1) & 1) * SHM_V + vst0) = vreg; a0 = n0; a1 = n1; a2 = n2; a3 = n3; }
    __syncthreads();
  }
#undef FV_SRC
#undef FA_LOAD
  { const int mc = 768 + cb * 64 + r32;
    unsigned short zv[16][2];
#pragma unroll
    for (int r = 0; r < 16; ++r) { const bf16* zr = F.PROJ() + (rowbase + k0 + crow(r, hi)) * LDP + C_Z + mc; zv[r][0] = zr[0]; zv[r][1] = zr[32]; }
#pragma unroll
    for (int r = 0; r < 16; ++r) { bf16* mr = F.PROJ() + (rowbase + k0 + crow(r, hi)) * LDP + C_Z + mc;
#pragma unroll
      for (int d = 0; d < 2; ++d) mr[32 * d] = (bf16)f2bf(o[d][r] * bf2f(zv[r][d])); } }
}

__device__ __forceinline__ void fft_unit(const Frame& F, int b, int cs, char* lds) {
  int tid_ = threadIdx.x; asm volatile("" : "+v"(tid_));
  const int tid = tid_, w = __builtin_amdgcn_readfirstlane(tid >> 6), lane = tid & 63, r32 = lane & 31, hi = lane >> 5;
  const long rowbase = NCTX + (long)b * 2048; const int col0 = cs * 8;
  const bf16* P = F.PROJ();
  bf16x8 a1[2][4], a2[2][8], zg[4];
  { bf16x8 v[8];
#pragma unroll
    for (int it = 0; it < 8; ++it) v[it] = ld8((const bf16*)(F.ws + WS_VFT) + ((size_t)(b * 32 + cs) * 4096 + it * 512 + tid) * 8);
    { const bf16* M1p = F.FM1() + r32 * 64 + hi * 8;
#pragma unroll
      for (int rh = 0; rh < 2; ++rh)
#pragma unroll
        for (int ks = 0; ks < 4; ++ks) a1[rh][ks] = ld8(M1p + rh * 32 * 64 + ks * 16); }
#pragma unroll
    for (int it = 0; it < 4; ++it) zg[it] = ld8(P + (rowbase + it * 512 + tid) * LDP + C_Z + 768 + col0);
#pragma unroll
    for (int it = 0; it < 8; ++it) { const int q = it * 512 + tid, ri = q >> 11, s = q & 2047, s1 = s >> 6, s2 = s & 63;
      *(bf16x8*)(lds + (s2 >> 4) * 16384 + v_st(ri * 32 + s1, (s2 & 15) * 8)) = v[it]; } }
  { const bf16* M2p = F.FM2() + r32 * 128 + hi * 8;
#pragma unroll
    for (int rh = 0; rh < 2; ++rh)
#pragma unroll
      for (int ks = 0; ks < 8; ++ks) a2[rh][ks] = ld8(M2p + rh * 32 * 128 + ks * 16); }
  __syncthreads();
  f32x16 o1[2][2];
  { const int vb = (int)(uintptr_t)lds + (w >> 1) * 16384 + (w & 1) * 1024 + v_rd_base(lane);
#pragma unroll
    for (int rh = 0; rh < 2; ++rh) { o1[rh][0] = f32x16{}; o1[rh][1] = f32x16{}; }
#pragma unroll
    for (int rh = 0; rh < 2; ++rh) { pv_one<0>(o1[rh][0], vb, a1[rh][0], a1[rh][1], a1[rh][2], a1[rh][3]); pv_one<1>(o1[rh][1], vb, a1[rh][0], a1[rh][1], a1[rh][2], a1[rh][3]); } }
  char* XB = lds + 65536;
  {
#pragma unroll
    for (int d = 0; d < 2; ++d) { const int s2 = 8 * w + d * 4 + (r32 >> 3), col = r32 & 7; const float s2f = (float)s2 * (1.f / 2048.f);
#pragma unroll
      for (int rq = 0; rq < 4; ++rq) { float yr[4], yi[4];
#pragma unroll
        for (int e = 0; e < 4; ++e) { const int r = 4 * rq + e, k1 = 8 * rq + 4 * hi + e; const float rev = (float)k1 * s2f;
          const float tc = __builtin_amdgcn_cosf(rev), tsn = __builtin_amdgcn_sinf(rev);
          const float xr = o1[0][d][r], xi = o1[1][d][r]; yr[e] = xr * tc + xi * tsn; yi[e] = xi * tc - xr * tsn; }
        const int off = (col >> 2) * 16384 + v_st(s2, (col & 3) * 32 + 8 * rq + 4 * hi);
        uint2 pr, pi; pr.x = cvtpk(yr[0], yr[1]); pr.y = cvtpk(yr[2], yr[3]); pi.x = cvtpk(yi[0], yi[1]); pi.y = cvtpk(yi[2], yi[3]);
        *(uint2*)(XB + off) = pr; *(uint2*)(XB + 2 * 16384 + off) = pi; } } }
  __syncthreads();
  f32x16 o2[2];
  { const int vre = (int)(uintptr_t)XB + (w >> 2) * 16384 + (w & 3) * 512 + v_rd_base(lane), vim = vre + 2 * 16384;
#pragma unroll
    for (int rh = 0; rh < 2; ++rh) { o2[rh] = f32x16{};
      pv_one<0>(o2[rh], vre, a2[rh][0], a2[rh][1], a2[rh][2], a2[rh][3]); pv_one<0>(o2[rh], vim, a2[rh][4], a2[rh][5], a2[rh][6], a2[rh][7]); } }
  float* OUTS = (float*)lds;
#pragma unroll
  for (int rh = 0; rh < 2; ++rh)
#pragma unroll
    for (int r = 0; r < 16; ++r) { const int k = r32 + 32 * (crow(r, hi) + 32 * rh); OUTS[k * 8 + w] = o2[rh][r] * 0.02209708691207961f; }
  __syncthreads();
#pragma unroll
  for (int it = 0; it < 4; ++it) { const int k = it * 512 + tid; const long row = rowbase + k;
    const bf16x8 z = zg[it];
    const f32x4 x0 = *(const f32x4*)(OUTS + k * 8), x1 = *(const f32x4*)(OUTS + k * 8 + 4);
    u32x4 o; o.x = cvtpk(x0.x * bf2f((unsigned short)z[0]), x0.y * bf2f((unsigned short)z[1])); o.y = cvtpk(x0.z * bf2f((unsigned short)z[2]), x0.w * bf2f((unsigned short)z[3]));
    o.z = cvtpk(x1.x * bf2f((unsigned short)z[4]), x1.y * bf2f((unsigned short)z[5])); o.w = cvtpk(x1.z * bf2f((unsigned short)z[6]), x1.w * bf2f((unsigned short)z[7]));
    *(u32x4*)(F.PROJ() + row * LDP + C_Z + 768 + col0) = o; }
  __syncthreads();
}
#undef KSWZ
#undef SBAR
}

__device__ __forceinline__ void phase_prologue(Frame& F) {
    const int G = F.G, bid = blockIdx.x, tid = F.tid;
    {
        LAS float* sc = (LAS float*)(F.lds + RING_OFF);
        LAS float* red = (LAS float*)(F.lds + RING_OFF + 9 * 1024 * 4);
        bool have = false;
        for (int job = bid; job < 192; job += G) {
            if (!have) { for (int i = tid; i < 9 * 1024; i += 512) { const int p = i >> 10, k = i & 1023; const float v = p == 0 ? in_ptr(7)[k] : in_ptr(6)[(p - 1) * 1024 + k]; sc[i] = silu_f(v); } have = true; }
            __syncthreads();
            const int l = job / 48, j0 = (job % 48) * 64, ks = tid >> 6, jj = tid & 63;
            float acc[9];
#pragma unroll
            for (int p = 0; p < 9; ++p) acc[p] = 0.f;
            const float* wp = in_ptr(8) + ((size_t)l * 1024 + ks * 128) * 3072 + j0 + jj;
            for (int k0 = 0; k0 < 128; k0 += 32) { float wl[32];
#pragma unroll
                for (int kk = 0; kk < 32; ++kk) wl[kk] = wp[(size_t)(k0 + kk) * 3072];
#pragma unroll
                for (int kk = 0; kk < 32; ++kk)
#pragma unroll
                    for (int p = 0; p < 9; ++p) acc[p] += sc[p * 1024 + ks * 128 + k0 + kk] * wl[kk]; }
#pragma unroll
            for (int p = 0; p < 9; ++p) red[(ks * 64 + jj) * 9 + p] = acc[p];
            __syncthreads();
            for (int i = tid; i < 64 * 9; i += 512) { const int j2 = i / 9, p = i % 9; float s = 0.f;
#pragma unroll
                for (int q = 0; q < 8; ++q) s += red[(q * 64 + j2) * 9 + p];
                F.MOD()[((size_t)l * 9 + p) * 3072 + j0 + j2] = s + in_ptr(9)[l * 3072 + j0 + j2]; }
        }
        __syncthreads();
    }
    const long gt = (long)bid * 512 + tid, NGT = (long)G * 512;
    for (long i = gt; i < 4 * 4 * 64 * 128; i += NGT) {
        const int n2 = (int)(i & 127), c = (int)((i >> 7) & 63), lg = (int)(i >> 13); const int ri = n2 >> 6, d = n2 & 63;
        const float* wf = in_ptr(18) + (size_t)lg * 4096 + d; float s = 0.f;
        for (int j = 0; j < 64; ++j) { const float ang = (float)((j * c) & 63) * (6.283185307179586f / 64.f); const float t = ri ? -sinf(ang) : cosf(ang); s += t * wf[j * 64]; }
        F.GF()[i] = s * 0.125f;
    }
    for (long i = gt; i < 1024; i += NGT) { const int pos = (int)(i >> 4), fi = (int)(i & 15); const float inv = powf(10000.f, -(float)fi / 16.f); const float ang = (float)pos * inv; F.ROPE()[i] = cosf(ang); F.ROPE()[1024 + i] = sinf(ang); }
    if (gt < 4) { const int l = (int)gt; float s1 = 0.f, s2 = 0.f;
        for (int k = 0; k < 64; ++k) { s1 += in_ptr(12)[l * 64 + k] * in_ptr(13)[l * 64 + k]; s2 += in_ptr(14)[l * 64 + k] * in_ptr(15)[l * 64 + k]; }
        const float li = 0.8f - 0.6f * expf(-0.3f * (float)l);
        F.ROPE()[2048 + 2 * l] = expf(s1) - expf(s2) + li; F.ROPE()[2048 + 2 * l + 1] = 1.f - li; }
    for (long i = gt; i < 64 * 64; i += NGT) { const int rr = (int)(i >> 6), cc = (int)(i & 63); const int rip = rr >> 5, k1 = rr & 31, ri = cc >> 5, s1 = cc & 31;
        const float ang = (float)((k1 * s1) & 31) * (6.283185307179586f / 32.f); const float cs = cosf(ang), sn = sinf(ang);
        F.FM1()[i] = (bf16)f2bf(rip == ri ? cs : (rip == 0 ? sn : -sn)); }
    for (long i = gt; i < 64 * 128; i += NGT) { const int k2 = (int)(i >> 7), cc = (int)(i & 127); const int s2 = cc & 63;
        const float ang = (float)((k2 * s2) & 63) * (6.283185307179586f / 64.f); F.FM2()[i] = (bf16)f2bf(cc < 64 ? cosf(ang) : sinf(ang)); }
    for (long i = gt; i < 2048; i += NGT) { const float ang = (float)i * (6.283185307179586f / 2048.f); F.FT2()[2 * i] = cosf(ang); F.FT2()[2 * i + 1] = sinf(ang); }
    for (long i = gt; i < 256L * 512 / 8; i += NGT) { const int k = (int)(i >> 6), c0 = (int)(i & 63) * 8; const int part = c0 >> 8; v4u o; unsigned short h[8];
#pragma unroll
        for (int e = 0; e < 8; ++e) { const int s = (c0 + e) & 255; const float ang = (float)((k * s) & 255) * (6.283185307179586f / 256.f); const float t = part ? sinf(ang) : cosf(ang); h[e] = (unsigned short)f2bf(t * 0.0625f); }
        o.x = h[0] | ((unsigned)h[1] << 16); o.y = h[2] | ((unsigned)h[3] << 16); o.z = h[4] | ((unsigned)h[5] << 16); o.w = h[6] | ((unsigned)h[7] << 16);
        *(GAS v4u*)(F.DFTC() + i * 8) = o; }
}
__device__ __forceinline__ void weight_prep(Frame& F, int l, int gw, int NGW, int gt, int NGT, int pwave, int plane, int which = 7) {
    if (which & 5) {
        LAS float* scr = (LAS float*)(F.lds + RING_OFF + pwave * 16384);
        constexpr int I_IN = 16 * 104, I_OUT = 16 * 32, I_FOLD = 1024, NITEMS = I_FOLD + I_IN + I_OUT;
        const float* win_l = in_ptr(11) + (size_t)l * DM * NIN; const float* wout_l = in_ptr(19) + (size_t)l * DM * DM;
        for (int it = gw; it < NITEMS; it += NGW) {
            int r = it;
            if (r < I_FOLD) { if (which & 4) fold_item(win_l, F.GF() + (size_t)l * 4 * 64 * 128, F.WIN(l), scr, r, plane); continue; } r -= I_FOLD;
            if (!(which & 1)) break;
            if (r < I_IN) { const int nb = r % 104; if (nb >= 64 && nb < 72) continue; p0_transpose_item(win_l, DM, NIN, F.WIN(l), nb >= 72 ? 256 : 0, scr, r, plane); continue; } r -= I_IN;
            p0_transpose_item(wout_l, DM, DM, F.WOUT(l), 0, scr, r, plane);
        }
    }
    if (which & 2) {
        constexpr int NA = 8 * 256 * 512 / 8, NB = 8 * 256 * 128 / 8;
        for (int i = gt; i < 2 * NA + 2 * NB; i += NGT) {
            const float* src; bf16* dst;
            if (i < 2 * NA) { const bool isv = i >= NA; const int e = (isv ? i - NA : i) * 8; const int b = (int)(e >> 17), t = (int)(e >> 9) & 255, h = (int)(e >> 7) & 3, c8 = (int)e & 127;
                src = in_ptr(isv ? 3 : 2) + ((long)(b * 4 + l) << 17) + (e & 131071); dst = (bf16*)(F.ws + (isv ? WS_VAL : WS_KAL)) + ((size_t)(b * 4 + h) * 2304 + 2048 + t) * 128 + c8; }
            else { const int i2 = i - 2 * NA; const bool isv = i2 >= NB; const int e = (isv ? i2 - NB : i2) * 8; const int b = (int)(e >> 15), t = (int)(e >> 7) & 255, kvh = (int)(e >> 6) & 1, c8 = (int)e & 63;
                src = in_ptr(isv ? 5 : 4) + ((long)(b * 4 + l) << 15) + (e & 32767); dst = (bf16*)(F.ws + (isv ? WS_VBL : WS_KBL)) + ((size_t)(b * 2 + kvh) * 2304 + 2048 + t) * 64 + c8; }
            const f32x4 a = *(const f32x4*)src, c = *(const f32x4*)(src + 4);
            v4u o; o.x = pk2(a.x, a.y); o.y = pk2(a.z, a.w); o.z = pk2(c.x, c.y); o.w = pk2(c.z, c.w);
            *(GAS v4u*)dst = o;
        }
    }
}
__device__ __forceinline__ void stream_rows(Frame& F, int l, int r0, int w0, int wn) {
    int tid_ = threadIdx.x; asm volatile("" : "+v"(tid_));
    const int plane = tid_ & 63, pwave = __builtin_amdgcn_readfirstlane(tid_ >> 6);
    float* X = F.out;
    const float* ng = l == DEPTH ? in_ptr(20) : in_ptr(10) + l * DM;
    for (int i = pwave; i < wn; i += 2 * NWAVES) {
        const float* xprev[2]; const bf16* drow[2]; float* xw[2]; bf16* hn[2]; float* yrow[2]; const float* scale[2]; const float* shift[2];
#pragma unroll
        for (int r = 0; r < 2; ++r) {
            const int ii = i + r * NWAVES; const bool on = ii < wn; const int m = r0 + w0 + (on ? ii : i);
            const bool ctx = m < NCTX; const int p = ctx ? 0 : 1 + ((m - NCTX) >> 11);
            const float* xin = ctx ? in_ptr(0) + (size_t)m * DM : in_ptr(1) + (size_t)(m - NCTX) * DM;
            xprev[r] = on ? (l <= 1 ? xin : X + (size_t)m * DM) : nullptr;
            drow[r] = l == 0 ? nullptr : F.ACT() + (size_t)m * DM;
            xw[r] = (l == 0 || l == DEPTH) ? nullptr : X + (size_t)m * DM;
            hn[r] = F.ACT() + (size_t)m * DM; yrow[r] = X + (size_t)m * DM;
            const float* mp = F.MOD() + ((size_t)(l == DEPTH ? 0 : l) * 9 + p) * 3072; scale[r] = mp + 1024; shift[r] = mp;
        }
        if (l == DEPTH) stream_row<true, 2>(xprev, drow, xw, hn, yrow, ng, scale, shift, plane);
        else stream_row<false, 2>(xprev, drow, xw, hn, yrow, ng, scale, shift, plane);
    }
}
__device__ __forceinline__ void even_share(int n, int G_, int c, int& w0, int& wn) { int G = G_; asm volatile("" : "+s"(G));
    const int q = n / G, r = n % G; w0 = c * q + (c < r ? c : r); wn = q + (c < r ? 1 : 0); }
__device__ __forceinline__ void mix_list(Frame& F, int l, bool lat, char* lds) {
    int bid_ = blockIdx.x; asm volatile("" : "+s"(bid_));
    const int np = lat ? 1280 : 768;
    for (int p = bid_; p < np; p += F.G) {
        int type = -1, path = lat ? 1 : 0, b = 0, hh = 0, qb = 0;
        if (lat) {
            if (p < 512) { const int seg = p >> 8, within = p & 255, x = within & 7, li = within >> 3, idx = seg * 32 + li, j = idx >> 4, bh = x + 8 * j; type = 0; qb = idx & 15; b = bh >> 2; hh = bh & 3; }
            else if (p < 768) { const int u = p - 512, x = u & 7, li = u >> 3; type = 1; b = x; hh = li >> 4; qb = li & 15; }
            else if (p >= 896 && p < 1024) { const int u = p - 896; type = 3; b = u >> 5; hh = u & 31; }
            else if (p >= 1152) { const int u = p - 1152 + 128; type = 3; b = u >> 5; hh = u & 31; }
        } else {
            if (p < 256) { type = 0; b = p >> 3; hh = (p >> 1) & 3; qb = p & 1; }
            else if (p >= 384 && p < 512) { const int u = p - 384; type = 1; b = u >> 2; hh = (u >> 1) & 1; qb = u & 1; }
            else if (p >= 640) { const int u = p - 640; type = 2; b = u >> 2; hh = u & 3; }
        }
        if (type == 0) att::attn_unit<0>(F, l, path, b, hh, qb, lds);
        if (type == 1) att::attn_unit<1>(F, l, path, b, hh, qb, lds);
        if (type == 2) att::fourier_unit(F, 0, b, 0, hh, lds);
        if (type == 3) att::fft_unit(F, b, hh, lds);
    }
}
struct Args { const float* in[21]; float* out; unsigned char* ws; };
__global__ void __launch_bounds__(NWAVES * 64, 2) mk_fwd(Args args) {
    extern __shared__ __attribute__((aligned(16))) unsigned char lds[];
    Frame F;
    F.lds = (LAS unsigned char*)lds;
    F.tid = threadIdx.x; F.lane = F.tid & 63; F.wave = __builtin_amdgcn_readfirstlane(F.tid >> 6);
    F.G = gridDim.x;
    unsigned char* ws = args.ws;
    F.out = args.out; F.ws = ws;
    for (int u = F.tid; u < (LDS_BYTES - LDSCTL_OFF) / 4; u += NWAVES * 64) ((LAS unsigned*)(F.lds + LDSCTL_OFF))[u] = 0u;
    __syncthreads();
    (void)xcd_barrier_post((unsigned*)ws + CW_BAR, (volatile LAS unsigned*)(F.lds + MISC_OFF) + 8);
#ifdef PROBE_BAR2
#define GRID_BAR() do { GRID_BAR1(); GRID_BAR1(); } while (0)
#else
#define GRID_BAR() GRID_BAR1()
#endif
#define GRID_BAR1() do { XcdBarrier bar_; bar_.bar = (unsigned*)F.ws + CW_BAR; bar_.x = xb_xcc_id(); bar_.st = (volatile LAS unsigned*)(F.lds + MISC_OFF) + 8; xcd_barrier(bar_); } while (0)

#ifdef PROBE_T
    unsigned long long tacc_ = 0, t0_ = 0;
#define TSTART(id) do { if (PROBE_T == (id)) t0_ = rt(); } while (0)
#define TSTOP(id) do { if (PROBE_T == (id)) tacc_ += rt() - t0_; } while (0)
#define TSPIN() do { if (blockIdx.x == 0) { const unsigned long long ts_ = rt(); while (rt() - ts_ < tacc_) __builtin_amdgcn_s_sleep(8); } } while (0)
#else
#define TSTART(id) do {} while (0)
#define TSTOP(id) do {} while (0)
#define TSPIN() do {} while (0)
#endif
    const int G = F.G, c = (int)blockIdx.x, H = G / 2;
    char* ldsg = (char*)lds + RING_OFF;
    TSTART(1); phase_prologue(F);
    {
        int tid_ = threadIdx.x; asm volatile("" : "+v"(tid_)); const int plane = tid_ & 63, pwave = __builtin_amdgcn_readfirstlane(tid_ >> 6);
        weight_prep(F, 0, c * NWAVES + pwave, G * NWAVES, 0, 1, pwave, plane, 1);
    }
    GRID_BAR();
    {
        int tid_ = threadIdx.x; asm volatile("" : "+v"(tid_)); const int plane = tid_ & 63, pwave = __builtin_amdgcn_readfirstlane(tid_ >> 6);
        weight_prep(F, 0, c * NWAVES + pwave, G * NWAVES, c * 512 + tid_, G * 512, pwave, plane, 6);
        int w0, wn; even_share(NCTX, G, c, w0, wn); stream_rows(F, 0, 0, w0, wn);
    }
    GRID_BAR(); TSTOP(1);
    for (int s = 0; s < 4 * DEPTH; ++s) {
        const int l = s >> 2, ph = s & 3; const bool lat = (ph == 1 || ph == 3);
        const int pm0 = lat ? 32 : 0, rows = lat ? NLAT : NCTX;
        if (ph < 2) {
            TSTART(2 + ph);
            pg8::Gemm g{F.ACT(), F.WIN(l), rows, NPROJ, DM, DM}; pg8::StaticOrder S; S.init(rows, NPROJ, G, c, pm0);
            pg8::EpiInProj E{F.ws, F.out, l};
            pg8::gemm_phase<pg8::EpiInProj, pg8::StaticOrder, true, true>(F.lds + RING_OFF, g, S, E);
            if (ph == 0) {
                int w0, wn;
                if (G == 256) { if (c < 192) { w0 = c * 52; wn = 52; } else { w0 = 192 * 52 + (c - 192) * 100; wn = 100; } } else even_share(NLAT, G, c, w0, wn);
                stream_rows(F, l, NCTX, w0, wn);
            } else mix_list(F, l, false, ldsg);
            GRID_BAR(); TSTOP(2 + ph);
        } else {
            TSTART(2 + ph);
            pg8::Gemm g{F.PROJ() + C_Z, F.WOUT(l), rows, DM, DM, LDP}; pg8::StaticOrder S; S.init(rows, DM, G, c, pm0);
            pg8::EpiDelta E{F.ws, l};
            pg8::gemm_phase<pg8::EpiDelta, pg8::StaticOrder, true, true>(F.lds + RING_OFF, g, S, E);
            if (ph == 2) { mix_list(F, l, true, ldsg);
            } else {
                int w0, wn; even_share(NCTX, G, c, w0, wn); stream_rows(F, l + 1, 0, w0, wn);
                if (l + 1 < DEPTH) { int tid_ = threadIdx.x; asm volatile("" : "+v"(tid_)); const int plane = tid_ & 63, pwave = __builtin_amdgcn_readfirstlane(tid_ >> 6);
                    weight_prep(F, l + 1, c * NWAVES + pwave, G * NWAVES, c * 512 + tid_, G * 512, pwave, plane); }
            }
            GRID_BAR(); TSTOP(2 + ph);
        }
    }
    TSTART(6); { int w0, wn; even_share(NLAT, G, c, w0, wn); stream_rows(F, DEPTH, NCTX, w0, wn); } TSTOP(6);
    TSPIN();
#undef GRID_BAR
}

extern "C" void kernel_launch(void* const* d_in, const int* in_sizes, int n_in, void* d_out, int out_size, void* d_ws, size_t ws_size, hipStream_t stream) {
    static int grid = 0;
    if (grid == 0) {
        if (n_in != 21 || ws_size < WS_END) { fprintf(stderr, "kernel_launch: built for 21 inputs and >= %zu bytes of workspace; got n_in %d, ws %zu\n", (size_t)WS_END, n_in, ws_size); grid = -1; return; }
        int dev = 0, cus = 0, per_cu = 0;
        if (hipGetDevice(&dev) != hipSuccess || hipDeviceGetAttribute(&cus, hipDeviceAttributeMultiprocessorCount, dev) != hipSuccess) { grid = -1; return; }
        if (hipFuncSetAttribute((const void*)mk_fwd, hipFuncAttributeMaxDynamicSharedMemorySize, LDS_BYTES) != hipSuccess) { fprintf(stderr, "kernel_launch: hipFuncSetAttribute failed\n"); grid = -1; return; }
        if (hipOccupancyMaxActiveBlocksPerMultiprocessor(&per_cu, (const void*)mk_fwd, NWAVES * 64, LDS_BYTES) != hipSuccess || per_cu < 1) fprintf(stderr, "kernel_launch: occupancy query reports %d\n", per_cu);
        (void)hipGetLastError();
        grid = cus;
    }
    if (grid < 0) return;
    if (hipMemsetAsync((char*)d_ws + WS_CTL, 0, CTL_ZERO_BYTES, stream) != hipSuccess) return;
    Args a{};
    for (int i = 0; i < 21; ++i) a.in[i] = (const float*)d_in[i];
    a.out = (float*)d_out; a.ws = (unsigned char*)d_ws;
    hipLaunchKernelGGL(mk_fwd, dim3(grid), dim3(NWAVES * 64), LDS_BYTES, stream, a);
    const hipError_t le = hipPeekAtLastError();
    if (le != hipSuccess) fprintf(stderr, "kernel_launch: launch failed: %s\n", hipGetErrorName(le));
}
```

```cpp
#include <hip/hip_runtime.h>
#include <cstdio>
#include <cstdint>
#include <cmath>
constexpr int DM = 1024, NCTX = 8192, NLAT = 16384, MTOK = NCTX + NLAT, DEPTH = 4, LDP = 2304, NPROJ = 3584, NIN = 3328;
constexpr int C_QA = 0, C_QB = 512, C_VF = 768, C_Z = 1280;
constexpr int NWAVES = 8;
constexpr float RMS_EPS = 1e-6f;
constexpr float QSCALE = 0.125f * 1.4426950408889634f;
constexpr size_t MiB = 1u << 20;
constexpr size_t WS_CTL = 0, CTL_ZERO_BYTES = 1 * MiB;
constexpr size_t WS_MOD = 1 * MiB;
constexpr size_t WS_G = WS_MOD + MiB / 2;
constexpr size_t WS_ROPE = 2 * MiB;
constexpr size_t WS_DFTC = 2 * MiB + MiB / 4;
constexpr size_t WS_FM1 = 3 * MiB;
constexpr size_t WS_FM2 = WS_FM1 + 8192;
constexpr size_t WS_ROWSS = MiB / 2;
constexpr size_t WS_GS = 2 * MiB + 65536;
constexpr size_t WS_BIAS = 2 * MiB + MiB / 2;
constexpr size_t WS_WIN = 4 * MiB;
constexpr size_t WS_WOUT = 11 * MiB, WOUT_BYTES = 2 * MiB;
constexpr size_t WS_ACT = 15 * MiB;
constexpr size_t WS_PROJ = 63 * MiB;
constexpr size_t WS_KAL = 171 * MiB, WS_VAL = 189 * MiB;
constexpr size_t WS_KAC = 207 * MiB, WS_VAC = 215 * MiB;
constexpr size_t WS_KBL = 223 * MiB, WS_VBL = WS_KBL + 9 * MiB / 2;
constexpr size_t WS_KBC = 232 * MiB, WS_VBC = 234 * MiB;
constexpr size_t WS_VFT = 236 * MiB;
constexpr size_t WS_END = 252 * MiB;
static_assert(WS_PROJ + (size_t)MTOK * LDP * 2 <= WS_KAL && WS_ACT + (size_t)MTOK * DM * 2 <= WS_PROJ && WS_KAL + 8ull * 4 * 2304 * 128 * 2 <= WS_VAL && WS_KBL + 8ull * 2 * 2304 * 64 * 2 <= WS_VBL && WS_VBL + 8ull * 2 * 2304 * 64 * 2 <= WS_KBC && WS_VBC + 32ull * 2 * 256 * 64 * 2 <= WS_VFT && WS_VFT + 8ull * 32 * 2 * 2048 * 8 * 2 <= WS_END, "ws map");
static_assert(WS_WIN + (size_t)NPROJ * DM * 2 <= WS_WOUT && WS_WOUT + 2 * WOUT_BYTES <= WS_ACT, "ws map (weights)");
constexpr int CW_BAR = 4096;
constexpr int RING_OFF = 0, RING_BYTES = 131072;
constexpr int LDSCTL_OFF = RING_BYTES, MISC_OFF = LDSCTL_OFF + 320;
constexpr int LDS_BYTES = 147456;

typedef const float* cfp_t;
typedef __attribute__((address_space(4))) const char* kaptr_t;
typedef __attribute__((address_space(4))) const cfp_t* kcfp_t;
__device__ __forceinline__ const float* in_ptr(int i) {
    kaptr_t ka = (kaptr_t)__builtin_amdgcn_kernarg_segment_ptr();
    asm volatile("" : "+s"(ka));
    return *(kcfp_t)(ka + 8 * i);
}
namespace pg8 {
#define PG8_LAS __attribute__((address_space(3)))
typedef unsigned short bf16_t;
typedef short bf16x8 __attribute__((ext_vector_type(8)));
typedef float f32x4 __attribute__((ext_vector_type(4)));
typedef unsigned u32x4 __attribute__((ext_vector_type(4)));
constexpr int BM = 256, BK = 64, HALF = 128, HTB = HALF * BK * 2  , STAGE_BYTES = 8 * HTB, NXCD = 8, WGM = 8;

__host__ __device__ __forceinline__ int lds_byte(int r, int c) { const int st = (r >> 4) * 2 + (c >> 5), rr = r & 15, cc = c & 31, ob = rr * 64 + cc * 2; return st * 1024 + (ob ^ (((ob >> 9) & 1) << 5)); }
__host__ __device__ __forceinline__ void stage_rc(int b, int& R, int& C) { const int st = b / 1024, sb = b % 1024, swz = sb ^ (((sb >> 9) & 1) << 5); R = (st >> 1) * 16 + swz / 64; C = (st & 1) * 32 + (swz % 64) / 2; }
__host__ __device__ __forceinline__ int perm32(int rho) { const int n = rho >> 4, i = rho & 15; return 8 * (i >> 2) + 4 * n + (i & 3); }

struct Unit { int pm, pn; };
struct Gemm { const bf16_t* A; const bf16_t* Bt; int M, N, K, lda; };

struct StaticOrder {
    int nM, nN, nwg, G, c, pm0;
    __host__ __device__ void init(int M, int N, int G_, int c_, int pm0_ = 0) { nM = M / BM; nN = N / BM; nwg = nM * nN; G = G_; c = c_; pm0 = pm0_; }
    __host__ __device__ bool next(int i, Unit& u) const {
        const long L = (long)i * G + c; if (L >= nwg) return false;
        int wgid = (int)L; { const int q = nwg / NXCD, r = nwg % NXCD, xcd = wgid % NXCD, off = wgid / NXCD; wgid = (xcd < r ? xcd * (q + 1) : r * (q + 1) + (xcd - r) * q) + off; }
        const int nig = WGM * nN, gid = wgid / nig, fm = gid * WGM, gsz = (nM - fm) < WGM ? (nM - fm) : WGM;
        u.pm = pm0 + fm + ((wgid % nig) % gsz); u.pn = (wgid % nig) / gsz; return true;
    }
    __device__ __forceinline__ void a_ready(const Unit&) const {}
    __device__ __forceinline__ void done(const Unit&) const {}
};

__device__ __forceinline__ unsigned cvt_pk_bf16(float lo, float hi) { unsigned r; asm volatile("v_cvt_pk_bf16_f32 %0, %1, %2" : "=v"(r) : "v"(lo), "v"(hi)); return r; }
struct EpiInProj {
    static constexpr bool PERM = true, AFTER_DRAIN = false;
    unsigned char* ws; float* out; int layer;
    __device__ __forceinline__ void operator()(const f32x4 (&acc)[2][2][4][2], const Unit& u, int wr, int wc, int fr_, int fq_) const {
        int fr = fr_, fq = fq_; asm volatile("" : "+v"(fr), "+v"(fq));
        const bool ctx = u.pm < 32;
        bf16_t* P = (bf16_t*)(ws + WS_PROJ); const float* rcos = (const float*)(ws + WS_ROPE); const float* rsin = rcos + 1024;
        float* o_dk = out + (size_t)MTOK * DM; float* o_dv = o_dk + 32L * 4 * 256 * 512; float* o_sk = o_dv + 32L * 4 * 256 * 512; float* o_sv = o_sk + 32L * 4 * 256 * 128;
#pragma unroll
        for (int bj = 0; bj < 2; ++bj) {
            const int colb = u.pn * 256 + bj * 128;
            const int col0 = colb + wc * 32 + 8 * fq;
            const bool rope = !ctx && (colb < 1024 || (colb >= 1536 && colb < 1920));
            const bool silu = colb >= 2560;
            const int bb = ctx ? u.pm : (u.pm - 32) >> 3, s0 = ctx ? 0 : ((u.pm - 32) & 7) * 256, SL = ctx ? 256 : 2304;
            bf16_t* dbase; int dld;
            if (colb < 512) { dbase = P + (size_t)u.pm * 256 * LDP + col0; dld = LDP; }
            else if (colb < 1536) { const bool isv = colb >= 1024; const int h = ((colb - 512) >> 7) & 3;
                bf16_t* kv = (bf16_t*)(ws + (ctx ? (isv ? WS_VAC : WS_KAC) : (isv ? WS_VAL : WS_KAL)));
                dbase = kv + ((size_t)(bb * 4 + h) * SL + s0) * 128 + wc * 32 + 8 * fq; dld = 128; }
            else if (colb < 1792) { dbase = P + (size_t)u.pm * 256 * LDP + C_QB + (col0 - 1536); dld = LDP; }
            else if (colb < 2048) { const bool isv = colb >= 1920; const int kvh = wc >> 1;
                bf16_t* kv = (bf16_t*)(ws + (ctx ? (isv ? WS_VBC : WS_KBC) : (isv ? WS_VBL : WS_KBL)));
                dbase = kv + ((size_t)(bb * 2 + kvh) * SL + s0) * 64 + (wc & 1) * 32 + 8 * fq; dld = 64; }
            else if (colb < 2560) {
                if (ctx) { dbase = P + (size_t)u.pm * 256 * LDP + C_VF + (col0 - 2048); dld = LDP; }
                else { const int vc = col0 - 2048, cs = (vc & 255) >> 3, ri = vc >> 8;
                    dbase = (bf16_t*)(ws + WS_VFT) + ((size_t)((bb * 32 + cs) * 2 + ri) * 2048 + s0) * 8; dld = 8; } }
            else { dbase = P + (size_t)u.pm * 256 * LDP + C_Z + (col0 - 2560); dld = LDP; }
            float* fo = nullptr; int fld = 0, fcol = 0;
            if (ctx) {
                if (colb >= 512 && colb < 1024) { fo = o_dk; fld = 512; fcol = col0 - 512; }
                else if (colb >= 1024 && colb < 1536) { fo = o_dv; fld = 512; fcol = col0 - 1024; }
                else if (colb == 1792) { fo = o_sk; fld = 128; fcol = col0 - 1792; }
                else if (colb == 1920) { fo = o_sv; fld = 128; fcol = col0 - 1920; }
            }
            const float sgn = (fq < 2) ? -1.f : 1.f;
            const int ti = 8 * (fq & 1);
#pragma unroll
            for (int ai = 0; ai < 2; ++ai)
#pragma unroll
                for (int m = 0; m < 4; ++m) {
                    const int row = u.pm * 256 + ai * 128 + wr * 64 + m * 16 + fr;
                    f32x4 v0 = acc[ai][bj][m][0], v1 = acc[ai][bj][m][1];
                    if (rope) {
                        const int s = (row - NCTX) & 2047; const int pos = (wc & 1) ? (s & 63) : (s >> 6);
                        const f32x4 c0 = *(const f32x4*)(rcos + pos * 16 + ti), c1 = *(const f32x4*)(rcos + pos * 16 + ti + 4);
                        const f32x4 s0 = *(const f32x4*)(rsin + pos * 16 + ti), s1 = *(const f32x4*)(rsin + pos * 16 + ti + 4);
                        f32x4 p0, p1;
#pragma unroll
                        for (int e = 0; e < 4; ++e) {
                            const unsigned a0 = __builtin_bit_cast(unsigned, (float)v0[e]), a1 = __builtin_bit_cast(unsigned, (float)v1[e]);
                            auto r0 = __builtin_amdgcn_permlane32_swap(a0, a0, false, false); auto r1 = __builtin_amdgcn_permlane32_swap(a1, a1, false, false);
                            p0[e] = __builtin_bit_cast(float, fq < 2 ? r0[1] : r0[0]); p1[e] = __builtin_bit_cast(float, fq < 2 ? r1[1] : r1[0]); }
                        v0 = v0 * c0 + (p0 * s0) * sgn; v1 = v1 * c1 + (p1 * s1) * sgn;
                    }
                    if (colb < 512 || (colb >= 1536 && colb < 1792)) { v0 = v0 * QSCALE; v1 = v1 * QSCALE; }
                    if (silu) {
#pragma unroll
                        for (int e = 0; e < 4; ++e) { v0[e] = v0[e] / (1.f + __expf(-v0[e])); v1[e] = v1[e] / (1.f + __expf(-v1[e])); }
                    }
                    u32x4 w; w.x = cvt_pk_bf16(v0[0], v0[1]); w.y = cvt_pk_bf16(v0[2], v0[3]); w.z = cvt_pk_bf16(v1[0], v1[1]); w.w = cvt_pk_bf16(v1[2], v1[3]);
                    *(u32x4*)(dbase + (size_t)(ai * 128 + wr * 64 + m * 16 + fr) * dld) = w;
                    if (fo) { const int b = row >> 8, s = row & 255; float* dst = fo + (size_t)((b * 4 + layer) * 256 + s) * fld + fcol; *(f32x4*)dst = v0; *(f32x4*)(dst + 4) = v1; }
                    asm volatile("" ::: "memory");
                }
        }
    }
};
struct EpiDelta {
    static constexpr bool PERM = true, AFTER_DRAIN = false;
    unsigned char* ws; int layer;
    __device__ __forceinline__ void operator()(const f32x4 (&acc)[2][2][4][2], const Unit& u, int wr, int wc, int fr_, int fq_) const {
        int fr = fr_, fq = fq_; asm volatile("" : "+v"(fr), "+v"(fq));
        const bool ctx = u.pm < 32; const int p = ctx ? 0 : 1 + ((u.pm - 32) >> 3);
        const float* gate = (const float*)(ws + WS_MOD) + ((size_t)layer * 9 + p) * 3072 + 2048;
        bf16_t* D = (bf16_t*)(ws + WS_ACT);
        const int row0 = u.pm * 256 + wr * 64 + fr, col0 = u.pn * 256 + wc * 32 + 8 * fq;
        f32x4 gv[2][2];
#pragma unroll
        for (int bj = 0; bj < 2; ++bj)
#pragma unroll
            for (int n = 0; n < 2; ++n) gv[bj][n] = *(const f32x4*)(gate + col0 + bj * 128 + 4 * n);
#pragma unroll
        for (int ai = 0; ai < 2; ++ai)
#pragma unroll
            for (int m = 0; m < 4; ++m) { bf16_t* rowp = D + (size_t)(row0 + ai * 128 + m * 16) * DM + col0;
#pragma unroll
                for (int bj = 0; bj < 2; ++bj) { const f32x4 v0 = acc[ai][bj][m][0] * gv[bj][0], v1 = acc[ai][bj][m][1] * gv[bj][1];
                    u32x4 w; w.x = cvt_pk_bf16(v0[0], v0[1]); w.y = cvt_pk_bf16(v0[2], v0[3]); w.z = cvt_pk_bf16(v1[0], v1[1]); w.w = cvt_pk_bf16(v1[2], v1[3]);
                    *(u32x4*)(rowp + bj * 128) = w; } }
    }
};
template <class Epi, class Sched, bool ALIGN_EPI = false, bool SP2 = false>
__device__ __forceinline__ void gemm_phase(PG8_LAS unsigned char* lds, const Gemm g, const Sched& S, const Epi& E) {
    int tid_ = threadIdx.x; asm volatile("" : "+v"(tid_));
    const int tid = tid_, wid = __builtin_amdgcn_readfirstlane(tid >> 6), lane = tid & 63, wr = wid >> 2, wc = wid & 3, fr = lane & 15, fq = lane >> 4;
    const int K = g.K, nt = K / BK;
    unsigned voffA[2], voffB[2];
#pragma unroll
    for (int i = 0; i < 2; ++i) { int R, C; stage_rc(tid * 16 + i * 8192, R, C); const int Rb = Epi::PERM ? ((R & ~31) + perm32(R & 31)) : R;
        voffA[i] = (unsigned)(R * g.lda + C) * 2u; voffB[i] = (unsigned)(Rb * K + C) * 2u; }
    const size_t kstep = (size_t)(BK * 2);
    const size_t hstep = (size_t)HALF * K * 2;
    const size_t tstep = 2 * hstep;
    const size_t hstepA = (size_t)HALF * g.lda * 2, tstepA = 2 * hstepA;
    const unsigned ldsw = (unsigned)wid * 1024u;
    const int aoff = lds_byte(wr * 64 + fr, fq * 8), boff = lds_byte(wc * 32 + fr, fq * 8);
#define PG8_SA(b, h) (((b) * 2 + (h)) * HTB)
#define PG8_SB(b, h) ((4 + (b) * 2 + (h)) * HTB)
#define PG8_STAGE(bufoff, gbase, voff) do { _Pragma("unroll") for (int _i = 0; _i < 2; ++_i) \
        __builtin_amdgcn_global_load_lds((const unsigned*)((const char*)(gbase) + (voff)[_i]), (PG8_LAS unsigned*)(lds + (bufoff) + ldsw + _i * 8192), 16, 0, 0); } while (0)
#define PG8_LDA(dst, b, h) do { _Pragma("unroll") for (int m = 0; m < 4; ++m) _Pragma("unroll") for (int k = 0; k < 2; ++k) dst[m][k] = *(const PG8_LAS bf16x8*)(lds + PG8_SA(b, h) + aoff + m * 2048 + k * 1024); } while (0)
#define PG8_LDB(dst, b, h) do { _Pragma("unroll") for (int n = 0; n < 2; ++n) _Pragma("unroll") for (int k = 0; k < 2; ++k) dst[n][k] = *(const PG8_LAS bf16x8*)(lds + PG8_SB(b, h) + boff + n * 2048 + k * 1024); } while (0)
#define PG8_MMA(ai, bj, At, Bt) do { __builtin_amdgcn_s_setprio(1); _Pragma("unroll") for (int m = 0; m < 4; ++m) _Pragma("unroll") for (int n = 0; n < 2; ++n) _Pragma("unroll") for (int k = 0; k < 2; ++k) \
        acc[ai][bj][m][n] = __builtin_amdgcn_mfma_f32_16x16x32_bf16(Bt[n][k], At[m][k], acc[ai][bj][m][n], 0, 0, 0); __builtin_amdgcn_s_setprio(0); } while (0)
#define PG8_WAIT_V(n) asm volatile("s_waitcnt vmcnt(" #n ")" ::: "memory")
#define PG8_WAIT_L(n) asm volatile("s_waitcnt lgkmcnt(" #n ")" ::: "memory")
#define PG8_BAR __builtin_amdgcn_s_barrier()
#define PG8_SCHED __builtin_amdgcn_sched_barrier(0)
    Unit cur, nxt; int ui = 0;
    if (!S.next(0, cur)) return;
    f32x4 acc[2][2][4][2];
#pragma unroll
    for (int a = 0; a < 2; ++a)
#pragma unroll
        for (int b = 0; b < 2; ++b)
#pragma unroll
            for (int m = 0; m < 4; ++m)
#pragma unroll
                for (int n = 0; n < 2; ++n) acc[a][b][m][n] = (f32x4){0.f, 0.f, 0.f, 0.f};
    bf16x8 At[4][2], B0[2][2], B1[2][2];
    const char* cA = (const char*)g.A + (size_t)cur.pm * tstepA; const char* cB = (const char*)g.Bt + (size_t)cur.pn * tstep;
    S.a_ready(cur);
    if constexpr (SP2) {
        PG8_STAGE(PG8_SB(0, 0), cB, voffB); PG8_STAGE(PG8_SB(0, 1), cB + hstep, voffB); PG8_STAGE(PG8_SA(0, 0), cA, voffA); PG8_STAGE(PG8_SA(0, 1), cA + hstepA, voffA);
        if (wr == 1) PG8_BAR;
        PG8_WAIT_V(2); PG8_BAR;
        PG8_STAGE(PG8_SB(1, 0), cB + kstep, voffB); PG8_STAGE(PG8_SA(1, 0), cA + kstep, voffA); PG8_STAGE(PG8_SB(1, 1), cB + hstep + kstep, voffB);
        PG8_WAIT_V(6); PG8_BAR;
    } else {
        PG8_STAGE(PG8_SB(0, 0), cB, voffB); PG8_STAGE(PG8_SA(0, 0), cA, voffA); PG8_STAGE(PG8_SB(0, 1), cB + hstep, voffB); PG8_STAGE(PG8_SA(0, 1), cA + hstepA, voffA);
        if (wr == 1) PG8_BAR;
        PG8_WAIT_V(4); PG8_BAR;
        PG8_STAGE(PG8_SB(1, 0), cB + kstep, voffB); PG8_STAGE(PG8_SA(1, 0), cA + kstep, voffA); PG8_STAGE(PG8_SB(1, 1), cB + hstep + kstep, voffB);
        PG8_WAIT_V(6); PG8_BAR;
    }
    for (;;) {
        const bool has_next = S.next(ui + 1, nxt);
        const char* nA = has_next ? (const char*)g.A + (size_t)nxt.pm * tstepA : cA; const char* nB = has_next ? (const char*)g.Bt + (size_t)nxt.pn * tstep : cB;
        for (int t = 0; t < nt; t += 2) {
            const bool last = (t == nt - 2);
            const char* a1 = cA + (size_t)(t + 1) * kstep;
            const char* a2 = last ? nA : cA + (size_t)(t + 2) * kstep; const char* b2 = last ? nB : cB + (size_t)(t + 2) * kstep;
            const char* a3 = a2 + kstep; const char* b3 = b2 + kstep;
            if (last && has_next) S.a_ready(nxt);
            if constexpr (SP2) {
            PG8_LDB(B0, 0, 0); PG8_LDB(B1, 0, 1); PG8_SCHED; PG8_LDA(At, 0, 0); PG8_STAGE(PG8_SA(1, 1), a1 + hstepA, voffA);
            PG8_WAIT_V(8); PG8_WAIT_L(0); PG8_BAR; PG8_MMA(0, 0, At, B0); PG8_MMA(0, 1, At, B1); PG8_BAR; PG8_SCHED;
            PG8_LDA(At, 0, 1); PG8_STAGE(PG8_SB(0, 0), b2, voffB); PG8_STAGE(PG8_SB(0, 1), b2 + hstep, voffB); PG8_STAGE(PG8_SA(0, 0), a2, voffA);
            PG8_WAIT_V(8); PG8_WAIT_L(0); PG8_BAR; PG8_MMA(1, 0, At, B0); PG8_MMA(1, 1, At, B1); PG8_BAR; PG8_SCHED;
            PG8_LDB(B0, 1, 0); PG8_LDB(B1, 1, 1); PG8_SCHED; PG8_LDA(At, 1, 0); PG8_STAGE(PG8_SA(0, 1), a2 + hstepA, voffA);
            PG8_WAIT_V(8); PG8_WAIT_L(0); PG8_BAR; PG8_MMA(0, 0, At, B0); PG8_MMA(0, 1, At, B1); PG8_BAR; PG8_SCHED;
            PG8_LDA(At, 1, 1); PG8_STAGE(PG8_SB(1, 0), b3, voffB); PG8_STAGE(PG8_SB(1, 1), b3 + hstep, voffB); PG8_STAGE(PG8_SA(1, 0), a3, voffA);
            PG8_WAIT_V(8); PG8_WAIT_L(0); PG8_BAR; PG8_MMA(1, 0, At, B0); PG8_MMA(1, 1, At, B1); PG8_BAR; PG8_SCHED;
            } else {
            PG8_LDB(B0, 0, 0); PG8_SCHED; PG8_LDA(At, 0, 0); PG8_STAGE(PG8_SA(1, 1), a1 + hstepA, voffA);
            PG8_WAIT_L(8); PG8_BAR; PG8_WAIT_L(0); PG8_MMA(0, 0, At, B0); PG8_BAR; PG8_SCHED;
            PG8_LDB(B1, 0, 1); PG8_STAGE(PG8_SB(0, 0), b2, voffB);
            PG8_BAR; PG8_WAIT_L(0); PG8_MMA(0, 1, At, B1); PG8_BAR;
            PG8_LDA(At, 0, 1); PG8_STAGE(PG8_SA(0, 0), a2, voffA);
            PG8_BAR; PG8_WAIT_L(0); PG8_MMA(1, 0, At, B0); PG8_BAR; PG8_SCHED;
            PG8_STAGE(PG8_SB(0, 1), b2 + hstep, voffB);
            PG8_WAIT_V(6); PG8_BAR; PG8_MMA(1, 1, At, B1); PG8_BAR;
            PG8_LDB(B0, 1, 0); PG8_SCHED; PG8_LDA(At, 1, 0); PG8_STAGE(PG8_SA(0, 1), a2 + hstepA, voffA);
            PG8_WAIT_L(8); PG8_BAR; PG8_WAIT_L(0); PG8_MMA(0, 0, At, B0); PG8_BAR; PG8_SCHED;
            PG8_LDB(B1, 1, 1); PG8_STAGE(PG8_SB(1, 0), b3, voffB);
            PG8_BAR; PG8_WAIT_L(0); PG8_MMA(0, 1, At, B1); PG8_BAR;
            PG8_LDA(At, 1, 1); PG8_STAGE(PG8_SA(1, 0), a3, voffA);
            PG8_BAR; PG8_WAIT_L(0); PG8_MMA(1, 0, At, B0); PG8_BAR; PG8_SCHED;
            PG8_STAGE(PG8_SB(1, 1), b3 + hstep, voffB);
            PG8_WAIT_V(6); PG8_BAR; PG8_MMA(1, 1, At, B1); PG8_BAR;
            }
        }
        if constexpr (ALIGN_EPI) { if (wr == 0) PG8_BAR; }
        if constexpr (!Epi::AFTER_DRAIN) { E(acc, cur, wr, wc, fr, fq); S.done(cur); }
        if (!has_next) break;
#pragma unroll
        for (int a = 0; a < 2; ++a)
#pragma unroll
            for (int b = 0; b < 2; ++b)
#pragma unroll
                for (int m = 0; m < 4; ++m)
#pragma unroll
                    for (int n = 0; n < 2; ++n) acc[a][b][m][n] = (f32x4){0.f, 0.f, 0.f, 0.f};
        cur = nxt; cA = nA; cB = nB; ++ui;
        if constexpr (ALIGN_EPI) { if (wr == 1) PG8_BAR; }
    }
    PG8_WAIT_V(0);
    if constexpr (!ALIGN_EPI) { if (wr == 0) PG8_BAR; }
    PG8_BAR;
    if constexpr (Epi::AFTER_DRAIN) { E.fused(acc, cur, wr, wc, fr, fq, lds, wid, lane); S.done(cur); }
#undef PG8_SA
#undef PG8_SB
#undef PG8_STAGE
#undef PG8_LDA
#undef PG8_LDB
#undef PG8_MMA
#undef PG8_WAIT_V
#undef PG8_WAIT_L
#undef PG8_BAR
#undef PG8_SCHED
}
}
#define GAS __attribute__((address_space(1)))
#define LAS __attribute__((address_space(3)))
typedef unsigned short bf16;
typedef unsigned v4u __attribute__((ext_vector_type(4)));
typedef float f32x4 __attribute__((ext_vector_type(4)));
typedef short bf16x8 __attribute__((ext_vector_type(8)));
typedef GAS unsigned gu32;
typedef GAS unsigned long long gu64;
#define RLX_AGENT __ATOMIC_RELAXED, __HIP_MEMORY_SCOPE_AGENT
#define LDS_WAIT() asm volatile("s_waitcnt lgkmcnt(0)" ::: "memory")
#define VM_WAIT() asm volatile("s_waitcnt vmcnt(0)" ::: "memory")
__device__ __forceinline__ unsigned long long rt() { return __builtin_amdgcn_s_memrealtime(); }
__device__ __forceinline__ unsigned f2bf(float f) { unsigned u = __builtin_bit_cast(unsigned, f); return (u + 0x7fffu + ((u >> 16) & 1u)) >> 16; }
__device__ __forceinline__ unsigned pk2(float lo, float hi) { return f2bf(lo) | (f2bf(hi) << 16); }

#define XB_TMO      128
#define XB_XCNT(j)  (256  + 64 * (j))
#define XB_XSUB(j)  (1280 + 64 * (j))
#define XB_XGEN(j)  (2304 + 64 * (j))
#define XB_TOP      3328
#define XB_TOPGEN   3392
#define XCD_BAR_WORDS 3456
#define XB_SPIN_CAP (1u << 18)

__device__ __forceinline__ unsigned xb_ld(unsigned* p)              { return __hip_atomic_load(p, __ATOMIC_RELAXED, __HIP_MEMORY_SCOPE_AGENT); }
__device__ __forceinline__ unsigned xb_add(unsigned* p, unsigned v) { return __hip_atomic_fetch_add(p, v, __ATOMIC_RELAXED, __HIP_MEMORY_SCOPE_AGENT); }
__device__ __forceinline__ unsigned xb_xcc_id() { return (unsigned)__builtin_amdgcn_s_getreg((3 << 11) | 20) & 0xFu; }
#define XB_SPIN(cond, bar) do { unsigned _sp = 0; while (cond) { __builtin_amdgcn_s_sleep(1); \
    if ((++_sp & 255u) == 0u) { if (xb_ld(&(bar)[XB_TMO])) break; if (_sp > XB_SPIN_CAP) { atomicAdd(&(bar)[XB_TMO], 1u); break; } } } } while (0)

struct XcdBarrier {
    unsigned* bar; unsigned x;
    volatile LAS unsigned* st;
};

__device__ __forceinline__ XcdBarrier xcd_barrier_post(unsigned* bar, volatile LAS unsigned* st) {
    XcdBarrier b; b.bar = bar; b.x = xb_xcc_id(); b.st = st;
    if (threadIdx.x == 0) (void)xb_add(&bar[XB_XCNT(b.x)], 1u);
    return b;
}
__device__ __forceinline__ void xcd_barrier_complete(unsigned* bar, unsigned x, unsigned& nloc, unsigned& nx) {
    const unsigned G = gridDim.x * gridDim.y * gridDim.z;
    unsigned sum, cnt, mine, sp = 0u;
    for (;;) {
        sum = 0u; cnt = 0u; mine = 0u;
#pragma unroll
        for (unsigned j = 0; j < 16; ++j) { const unsigned c = xb_ld(&bar[XB_XCNT(j)]); sum += c; cnt += (c > 0u) ? 1u : 0u; mine = (j == x) ? c : mine; }
        if (sum == G) break;
        __builtin_amdgcn_s_sleep(1);
        if ((++sp & 255u) == 0u) { if (xb_ld(&bar[XB_TMO])) break; if (sp > XB_SPIN_CAP) { atomicAdd(&bar[XB_TMO], 1u); break; } }
    }
    nloc = mine > 0u ? mine : 1u; nx = cnt > 0u ? cnt : 1u;
}

__device__ __forceinline__ void xcd_barrier(const XcdBarrier& b) {
    asm volatile("s_waitcnt vmcnt(0)" ::: "memory");
    __syncthreads();
    if (threadIdx.x == 0) {
        unsigned* bar = b.bar;
        __builtin_amdgcn_s_waitcnt(0);
        unsigned nloc = b.st[0], nx = b.st[1];
        if (nloc == 0u) { xcd_barrier_complete(bar, b.x, nloc, nx); b.st[0] = nloc; b.st[1] = nx; }
        const unsigned old = xb_add(&bar[XB_XSUB(b.x)], 1u);
        const unsigned gen = old / nloc;
        if (old + 1u == (gen + 1u) * nloc) {
            __builtin_amdgcn_fence(__ATOMIC_RELEASE, "agent");
            asm volatile("s_waitcnt vmcnt(0)" ::: "memory");
            const unsigned og = xb_add(&bar[XB_TOP], 1u);
            const unsigned tg = og / nx;
            if (og + 1u == (tg + 1u) * nx) xb_add(&bar[XB_TOPGEN], 1u);
            else XB_SPIN(xb_ld(&bar[XB_TOPGEN]) == tg, bar);
            __builtin_amdgcn_fence(__ATOMIC_ACQUIRE, "agent");
            xb_add(&bar[XB_XGEN(b.x)], 1u);
            asm volatile("s_waitcnt vmcnt(0)" ::: "memory");
        } else {
            XB_SPIN(xb_ld(&bar[XB_XGEN(b.x)]) == gen, bar);
            __builtin_amdgcn_fence(__ATOMIC_ACQUIRE, "agent");
            asm volatile("s_waitcnt vmcnt(0)" ::: "memory");
        }
    }
    __syncthreads();
}

struct Frame {
    LAS unsigned char* lds;
    int tid, lane, wave, G;
    float* out;
    unsigned char* ws;
    __device__ __forceinline__ float* MOD() const { return (float*)(ws + WS_MOD); }
    __device__ __forceinline__ float* GF() const { return (float*)(ws + WS_G); }
    __device__ __forceinline__ float* ROPE() const { return (float*)(ws + WS_ROPE); }
    __device__ __forceinline__ bf16* DFTC() const { return (bf16*)(ws + WS_DFTC); }
    __device__ __forceinline__ bf16* FM1() const { return (bf16*)(ws + WS_FM1); }
    __device__ __forceinline__ bf16* FM2() const { return (bf16*)(ws + WS_FM2); }
    __device__ __forceinline__ bf16* WIN(int) const { return (bf16*)(ws + WS_WIN); }
    __device__ __forceinline__ bf16* WOUT(int l) const { return (bf16*)(ws + WS_WOUT + (size_t)(l & 1) * WOUT_BYTES); }
    __device__ __forceinline__ float* GS() const { return (float*)(ws + WS_GS); }
    __device__ __forceinline__ float* BIAS() const { return (float*)(ws + WS_BIAS); }
    __device__ __forceinline__ float* ROWSS() const { return (float*)(ws + WS_ROWSS); }
    __device__ __forceinline__ bf16* ACT() const { return (bf16*)(ws + WS_ACT); }
    __device__ __forceinline__ bf16* PROJ() const { return (bf16*)(ws + WS_PROJ); }
};
__device__ __forceinline__ float wave_sum(float v) {
#pragma unroll
    for (int o = 1; o < 64; o <<= 1) v += __shfl_xor(v, o);
    return v;
}
__device__ __forceinline__ float bf2f(unsigned short h) { return __builtin_bit_cast(float, (unsigned)h << 16); }
__device__ __forceinline__ float silu_f(float v) { return v / (1.f + __expf(-v)); }

__device__ __forceinline__ void p0_transpose_item(const float* W, int K, int N, bf16* WT, int row_off, LAS float* scr, int item, int lane) {
    const int nblk = N / 32, kb = item / nblk, nb = item % nblk, k0 = 64 * kb, n0 = 32 * nb;
    float wl[32];
#pragma unroll
    for (int i = 0; i < 32; ++i) { const int kk = 2 * i + (lane >> 5); wl[i] = W[(size_t)(k0 + kk) * N + n0 + (lane & 31)]; }
#pragma unroll
    for (int i = 0; i < 32; ++i) { const int kk = 2 * i + (lane >> 5); scr[kk * 33 + (lane & 31)] = wl[i]; }
    LDS_WAIT(); asm volatile("" ::: "memory");
    const int c = lane & 7;
#pragma unroll
    for (int j = 0; j < 4; ++j) { const int n = (lane >> 3) + 8 * j; const LAS float* s = scr + (8 * c) * 33 + n;
        v4u o; o.x = pk2(s[0 * 33], s[1 * 33]); o.y = pk2(s[2 * 33], s[3 * 33]); o.z = pk2(s[4 * 33], s[5 * 33]); o.w = pk2(s[6 * 33], s[7 * 33]);
        *(GAS v4u*)(WT + (size_t)(row_off + n0 + n) * K + k0 + 8 * c) = o; }
    LDS_WAIT(); asm volatile("" ::: "memory");
}
__device__ __forceinline__ void fold_item(const float* win_l, const float* G_l, bf16* WinT, LAS float* scr, int item, int lane) {
    const int kb = item >> 6, g = (item >> 4) & 3, nb = item & 15;
    const int k = kb * 64 + lane;
    const f32x4* src = (const f32x4*)(win_l + (size_t)k * NIN + 2048 + g * 64);
    const float* Gg = G_l + g * 64 * 128 + nb * 8;
    f32x4 wv[16];
#pragma unroll
    for (int i = 0; i < 16; ++i) wv[i] = src[i];
    { const f32x4 g0 = *(const f32x4*)(Gg + lane * 128), g1 = *(const f32x4*)(Gg + lane * 128 + 4);
      *(LAS f32x4*)(scr + lane * 8) = g0; *(LAS f32x4*)(scr + lane * 8 + 4) = g1; }
    LDS_WAIT(); asm volatile("" ::: "memory");
    float a[8];
#pragma unroll
    for (int nn = 0; nn < 8; ++nn) a[nn] = 0.f;
#pragma unroll
    for (int i = 0; i < 16; ++i)
#pragma unroll
        for (int e = 0; e < 4; ++e) { const float w = wv[i][e]; const int c = 4 * i + e;
            const f32x4 g0 = *(const LAS f32x4*)(scr + c * 8), g1 = *(const LAS f32x4*)(scr + c * 8 + 4);
            a[0] += w * g0.x; a[1] += w * g0.y; a[2] += w * g0.z; a[3] += w * g0.w; a[4] += w * g1.x; a[5] += w * g1.y; a[6] += w * g1.z; a[7] += w * g1.w; }
    LDS_WAIT(); asm volatile("" ::: "memory");
#pragma unroll
    for (int nn = 0; nn < 8; ++nn) { const int n2 = nb * 8 + nn; const int ri = n2 >> 6, d = n2 & 63; const int nrow = 2048 + ri * 256 + g * 64 + d;
        WinT[(size_t)nrow * 1024 + k] = (bf16)f2bf(a[nn]); }
}
template <bool FINAL, int NR>
__device__ __forceinline__ void stream_row(const float* const (&xprev)[NR], const bf16* const (&drow)[NR], float* const (&xw)[NR], bf16* const (&hn)[NR], float* const (&yrow)[NR],
                                           const float* g, const float* const (&scale)[NR], const float* const (&shift)[NR], int lane) {
    f32x4 v[NR][4]; unsigned long long dd[NR][4]; float s[NR];
#pragma unroll
    for (int r = 0; r < NR; ++r) if (xprev[r]) {
#pragma unroll
        for (int j = 0; j < 4; ++j) v[r][j] = ((const GAS f32x4*)xprev[r] + lane)[64 * j];
        if (drow[r]) {
#pragma unroll
            for (int j = 0; j < 4; ++j) dd[r][j] = *(const GAS unsigned long long*)(drow[r] + 4 * (lane + 64 * j)); }
    }
#pragma unroll
    for (int r = 0; r < NR; ++r) if (xprev[r]) {
        if (drow[r]) {
#pragma unroll
            for (int j = 0; j < 4; ++j) { const unsigned long long d = dd[r][j];
                v[r][j].x += bf2f((unsigned short)d); v[r][j].y += bf2f((unsigned short)(d >> 16)); v[r][j].z += bf2f((unsigned short)(d >> 32)); v[r][j].w += bf2f((unsigned short)(d >> 48)); }
        }
        float t = 0.f;
#pragma unroll
        for (int j = 0; j < 4; ++j) t += (v[r][j].x * v[r][j].x + v[r][j].y * v[r][j].y) + (v[r][j].z * v[r][j].z + v[r][j].w * v[r][j].w);
        s[r] = t;
    }
    f32x4 gv[4], scv[NR][4], shv[NR][4];
#pragma unroll
    for (int j = 0; j < 4; ++j) { const int k = 4 * (lane + 64 * j); gv[j] = *(const f32x4*)(g + k);
        if (!FINAL) {
#pragma unroll
            for (int r = 0; r < NR; ++r) { scv[r][j] = *(const f32x4*)(scale[r] + k); shv[r][j] = *(const f32x4*)(shift[r] + k); } } }
    float rstd[NR];
#pragma unroll
    for (int r = 0; r < NR; ++r) rstd[r] = xprev[r] ? 1.f / sqrtf(wave_sum(s[r]) * (1.f / DM) + RMS_EPS) : 0.f;
#pragma unroll
    for (int r = 0; r < NR; ++r) if (xprev[r]) {
        if (xw[r]) {
#pragma unroll
            for (int j = 0; j < 4; ++j) *((GAS f32x4*)xw[r] + lane + 64 * j) = v[r][j];
        }
#pragma unroll
        for (int j = 0; j < 4; ++j) {
            const int k = 4 * (lane + 64 * j);
            if (FINAL) { *(f32x4*)(yrow[r] + k) = v[r][j] * rstd[r] * gv[j]; }
            else {
                const f32x4 h = (v[r][j] * rstd[r]) * (gv[j] * (scv[r][j] + 1.f)) + shv[r][j];
                *(GAS unsigned long long*)(hn[r] + k) = (unsigned long long)pk2(h.x, h.y) | ((unsigned long long)pk2(h.z, h.w) << 32);
            }
        }
    }
}

namespace att {
using bf16x8 = __attribute__((ext_vector_type(8))) short;
using s16x4 = __attribute__((ext_vector_type(4))) short;
using f32x16 = __attribute__((ext_vector_type(16))) float;
using u32x4 = __attribute__((ext_vector_type(4))) unsigned;
constexpr int QBLK = 32, KVBLK = 64;
constexpr float SCALE = 0.125f;
constexpr float THR = 8.f;
constexpr int SHM_V = 64 * 128 * 2, SHM_K = 64 * 128 * 2;
#define KSWZ(row, colB) ((row) * 256 + ((colB) ^ (((row) & 7) << 4)))
#define SBAR() __builtin_amdgcn_sched_barrier(0)
__device__ __forceinline__ int crow(int r, int hi) { return (r & 3) + 8 * (r >> 2) + 4 * hi; }
__device__ __forceinline__ unsigned cvtpk(float lo, float hi) { unsigned r; asm volatile("v_cvt_pk_bf16_f32 %0, %1, %2" : "=v"(r) : "v"(lo), "v"(hi)); return r; }
__device__ __forceinline__ bf16x8 ld8(const bf16* p) { return *reinterpret_cast<const bf16x8*>(p); }

constexpr float THRL = 11.5f;
__device__ __forceinline__ void partialSM(f32x16& p0, f32x16& p1, float& mhat, f32x16& negm, float& alpha) {
  float pmax = p0[0];
#pragma unroll
  for (int r = 1; r < 16; ++r) pmax = fmaxf(pmax, p0[r]);
#pragma unroll
  for (int r = 0; r < 16; ++r) pmax = fmaxf(pmax, p1[r]);
  { auto rr = __builtin_amdgcn_permlane32_swap(__float_as_uint(pmax), __float_as_uint(pmax), false, false);
    pmax = fmaxf(__uint_as_float(rr[0]), __uint_as_float(rr[1])); }
  if (__builtin_expect(__all(pmax <= THRL), 1)) { alpha = 1.f; }
  else { const float dl = fmaxf(pmax, 0.f); mhat += dl; alpha = __builtin_amdgcn_exp2f(-dl);
#pragma unroll
    for (int r = 0; r < 16; ++r) { p0[r] -= dl; p1[r] -= dl; negm[r] = -mhat; } }
#pragma unroll
  for (int r = 0; r < 16; ++r) p0[r] = __builtin_amdgcn_exp2f(p0[r]);
}
__device__ __forceinline__ void finishSM(f32x16& p0, f32x16& p1, float alpha, float& l_reg, bf16x8& pa0, bf16x8& pa1, bf16x8& pa2, bf16x8& pa3) {
#pragma unroll
  for (int r = 0; r < 16; ++r) p1[r] = __builtin_amdgcn_exp2f(p1[r]);
  float ps = 0;
#pragma unroll
  for (int r = 0; r < 16; ++r) ps += p0[r];
#pragma unroll
  for (int r = 0; r < 16; ++r) ps += p1[r];
  { auto rr = __builtin_amdgcn_permlane32_swap(__float_as_uint(ps), __float_as_uint(ps), false, false);
    ps = __uint_as_float(rr[0]) + __uint_as_float(rr[1]); }
  l_reg = l_reg * alpha + ps;
#define PK4(P, BASE, OUT) do { unsigned a0 = cvtpk(P[BASE + 0], P[BASE + 1]), a1 = cvtpk(P[BASE + 2], P[BASE + 3]);   \
    unsigned b0 = cvtpk(P[BASE + 4], P[BASE + 5]), b1 = cvtpk(P[BASE + 6], P[BASE + 7]);                              \
    auto r0 = __builtin_amdgcn_permlane32_swap(a0, b0, false, false); auto r1 = __builtin_amdgcn_permlane32_swap(a1, b1, false, false); \
    u32x4 w = {r0[0], r1[0], r0[1], r1[1]}; OUT = *reinterpret_cast<bf16x8*>(&w); } while (0)
  PK4(p0, 0, pa0); PK4(p0, 8, pa1); PK4(p1, 0, pa2); PK4(p1, 8, pa3);
#undef PK4
}
template <int KP> __device__ __forceinline__ void qkt(f32x16& p0, f32x16& p1, const char* Ks, const bf16x8* qr, int r32, int hi, int kcb, const f32x16& negm) {
  p0 = negm; p1 = negm;
#pragma unroll
  for (int d0 = 0; d0 < 4; ++d0) { int cb = kcb + (d0 * 16 + hi * 8) * 2;
    bf16x8 b0 = *reinterpret_cast<const bf16x8*>(Ks + r32 * KP + (cb ^ ((r32 & 7) << 4)));
    bf16x8 b1 = *reinterpret_cast<const bf16x8*>(Ks + (32 + r32) * KP + (cb ^ ((r32 & 7) << 4)));
    p0 = __builtin_amdgcn_mfma_f32_32x32x16_bf16(b0, qr[d0], p0, 0, 0, 0);
    p1 = __builtin_amdgcn_mfma_f32_32x32x16_bf16(b1, qr[d0], p1, 0, 0, 0); }
}
__device__ __forceinline__ int v_st(int k, int c) { const int kk = (k & ~0xC) | ((k & 4) << 1) | ((k & 8) >> 1); return ((kk >> 3) * 4 + (c >> 5)) * 512 + ((kk & 7) * 32 + (c & 31)) * 2; }
__device__ __forceinline__ int v_rd_base(int lane) { return ((lane & 3) << 3) | (((lane >> 2) & 3) << 6) | (((lane >> 4) & 1) << 5) | (((lane >> 5) & 1) << 8); }
constexpr int v_rd_off(int d0, int ks, int half, bool w64 = false) { return w64 ? d0 * 512 + ks * 2048 + half * 1024 : d0 * 512 + ks * 4096 + half * 2048; }
template <int OFF> __device__ __forceinline__ s16x4 tr_read(int vb) {
  s16x4 r; asm volatile("ds_read_b64_tr_b16 %0, %1 offset:%2" : "=&v"(r) : "v"(vb), "i"(OFF) : "memory"); return r;
}
template <int D0, bool W64 = false> __device__ __forceinline__ void pv_one(f32x16& od, int vb, bf16x8 pa0, bf16x8 pa1, bf16x8 pa2, bf16x8 pa3) {
  const s16x4 l0 = tr_read<v_rd_off(D0, 0, 0, W64)>(vb), h0 = tr_read<v_rd_off(D0, 0, 1, W64)>(vb), l1 = tr_read<v_rd_off(D0, 1, 0, W64)>(vb), h1 = tr_read<v_rd_off(D0, 1, 1, W64)>(vb);
  const s16x4 l2 = tr_read<v_rd_off(D0, 2, 0, W64)>(vb), h2 = tr_read<v_rd_off(D0, 2, 1, W64)>(vb), l3 = tr_read<v_rd_off(D0, 3, 0, W64)>(vb), h3 = tr_read<v_rd_off(D0, 3, 1, W64)>(vb);
  asm volatile("s_waitcnt lgkmcnt(0)" ::: "memory"); SBAR();
#define PK(L, H) (bf16x8){L[0], L[1], L[2], L[3], H[0], H[1], H[2], H[3]}
  od = __builtin_amdgcn_mfma_f32_32x32x16_bf16(pa0, PK(l0, h0), od, 0, 0, 0);
  od = __builtin_amdgcn_mfma_f32_32x32x16_bf16(pa1, PK(l1, h1), od, 0, 0, 0);
  od = __builtin_amdgcn_mfma_f32_32x32x16_bf16(pa2, PK(l2, h2), od, 0, 0, 0);
  od = __builtin_amdgcn_mfma_f32_32x32x16_bf16(pa3, PK(l3, h3), od, 0, 0, 0);
#undef PK
}
template <int ND> __device__ __forceinline__ void pv_all(f32x16* o, int vb, bf16x8 pa0, bf16x8 pa1, bf16x8 pa2, bf16x8 pa3) {
  if constexpr (ND == 4) { pv_one<0>(o[0], vb, pa0, pa1, pa2, pa3); pv_one<1>(o[1], vb, pa0, pa1, pa2, pa3); pv_one<2>(o[2], vb, pa0, pa1, pa2, pa3); pv_one<3>(o[3], vb, pa0, pa1, pa2, pa3); }
  else { pv_one<0, true>(o[0], vb, pa0, pa1, pa2, pa3); pv_one<1, true>(o[1], vb, pa0, pa1, pa2, pa3); }
}
__device__ __forceinline__ void glds16(const void* gsrc, unsigned lds_dst) { unsigned keep;
  asm volatile("s_mov_b32 %0, m0\n\ts_mov_b32 m0, %2\n\ts_nop 0\n\tglobal_load_lds_dwordx4 %1, off\n\ts_mov_b32 m0, %0" : "=&s"(keep) : "v"(gsrc), "s"(lds_dst) : "memory"); }
struct TileSrc { const bf16* k; const bf16* v; int kpos0; };
template <int MODE> __device__ __forceinline__ TileSrc tile_src(const Frame& F, int path, int b, int hh, int qb, int j) {
  TileSrc t; t.kpos0 = -1;
  if (MODE == 0) {
    const size_t off = (path ? (size_t)(b * 4 + hh) * 2304 : (size_t)(b * 4 + hh) * 256) * 128 + (size_t)j * 64 * 128;
    t.k = (const bf16*)(F.ws + (path ? WS_KAL : WS_KAC)) + off; t.v = (const bf16*)(F.ws + (path ? WS_VAL : WS_VAC)) + off;
  } else {
    int kt = j;
    if (path) { const int nloc = 2 + (qb > 0 ? 2 : 0) + (qb < 15 ? 2 : 0);
      if (j < nloc) { if (j < 2) kt = 2 * qb + j; else if (qb > 0 && j < 4) kt = 2 * qb - 2 + (j - 2); else kt = 2 * qb + 2 + (j - (qb > 0 ? 4 : 2)); t.kpos0 = kt * 64; }
      else kt = 32 + (j - nloc); }
    const size_t off = (path ? (size_t)(b * 2 + hh) * 2304 : (size_t)(b * 2 + hh) * 256) * 64 + (size_t)kt * 64 * 64;
    t.k = (const bf16*)(F.ws + (path ? WS_KBL : WS_KBC)) + off; t.v = (const bf16*)(F.ws + (path ? WS_VBL : WS_VBC)) + off;
  }
  return t;
}
template <int MODE> struct Stg;
template <> struct Stg<0> { bf16x8 vs0, vs1, ks0, ks1; };
template <> struct Stg<1> { bf16x8 vs0, ks0; };

template <int MODE>
__device__ __forceinline__ void attn_unit(const Frame& F, int layer, int path, int b, int hh, int qb, char* lds) {
  constexpr int ND = MODE == 0 ? 4 : 2;
  int tid_ = threadIdx.x; asm volatile("" : "+v"(tid_));
  const int tid = tid_, wid = __builtin_amdgcn_readfirstlane(tid >> 6), lane = tid & 63, r32 = lane & 31, hi = lane >> 5;
  const int wq = wid & 3, wc = wid >> 2;
  constexpr int VB = MODE == 0 ? 16384 : 8192, SLOT = 2 * VB;
  constexpr int KP = MODE == 0 ? 256 : 128;
  constexpr int NP = MODE == 0 ? 2 : 1, NDMA = 2 * NP;
  float* ws = (float*)(lds + 131072 + 1024) + wid * 64; float* li_l = ws; float* al_l = ws + 32;
  const long rowbase = path ? NCTX + (long)b * 2048 : (long)b * 256;
  const long qrow0 = rowbase + qb * 128 + wq * 32;
  const int qcol = MODE == 0 ? C_QA + hh * 128 + wc * 64 : C_QB + (hh * 2 + wc) * 64;
  const int kcb = MODE == 0 ? wc * 128 : 0;
  const int NT = MODE == 0 ? (path ? 36 : 4) : (path ? 6 + (qb > 0 ? 2 : 0) + (qb < 15 ? 2 : 0) : 4);
  const int qpos = qb * 128 + wq * 32 + r32;
  float mhat = 0.f, l_reg = 0; f32x16 o[ND]; bf16x8 qr[4]; f32x16 negm = f32x16{};
#pragma unroll
  for (int d = 0; d < ND; ++d) o[d] = f32x16{};
  const unsigned lds0 = (unsigned)(uintptr_t)lds;
  const int vb0 = (int)lds0 + v_rd_base(lane);
  int ksrc[NP], vsrc[NP];
#pragma unroll
  for (int i = 0; i < NP; ++i) { const int o_ = (wid * NP + i) * 1024 + lane * 16;
    if (MODE == 0) { const int r = o_ >> 8, c_ = (o_ >> 4) & 15; ksrc[i] = r * 256 + ((c_ ^ (r & 7)) << 4);
      const int st = o_ >> 9, w_ = o_ & 511, kk = (st >> 2) * 8 + (w_ >> 6), k = (kk & ~0xC) | ((kk & 4) << 1) | ((kk & 8) >> 1), c = (st & 3) * 32 + ((w_ & 63) >> 1); vsrc[i] = k * 256 + c * 2; }
    else { const int r = o_ >> 7, c_ = (o_ >> 4) & 7; ksrc[i] = r * 128 + ((c_ ^ (r & 7)) << 4);
      const int st = o_ >> 9, w_ = o_ & 511, kk = (st >> 1) * 8 + (w_ >> 6), k = (kk & ~0xC) | ((kk & 4) << 1) | ((kk & 8) >> 1), c = (st & 1) * 32 + ((w_ & 63) >> 1); vsrc[i] = k * 128 + c * 2; } }
#define DMA_TILE(j_, so) do { const TileSrc ts_ = tile_src<MODE>(F, path, b, hh, qb, (j_)); \
    _Pragma("unroll") for (int i = 0; i < NP; ++i) { const unsigned d_ = lds0 + (unsigned)(so) + (unsigned)((wid * NP + i) * 1024); \
      glds16((const char*)ts_.v + vsrc[i], (unsigned)__builtin_amdgcn_readfirstlane(d_)); glds16((const char*)ts_.k + ksrc[i], (unsigned)__builtin_amdgcn_readfirstlane(d_ + VB)); } } while (0)
#define DMA_WAIT(n) do { if ((n) == 0) asm volatile("s_waitcnt vmcnt(0)" ::: "memory"); else if (NDMA == 4) asm volatile("s_waitcnt vmcnt(4)" ::: "memory"); else asm volatile("s_waitcnt vmcnt(2)" ::: "memory"); } while (0)
#define RESC(a) do { if (__any((a) < 1.f)) { if (hi == 0) al_l[r32] = (a); asm volatile("s_waitcnt lgkmcnt(0)" ::: "memory"); \
    _Pragma("unroll") for (int d = 0; d < ND; ++d) _Pragma("unroll") for (int r = 0; r < 16; ++r) o[d][r] *= al_l[crow(r, hi)]; } } while (0)
#define MASK(P0, P1, j_) do { if (MODE == 1 && path == 1 && (j_) >= 2) { const TileSrc tm_ = tile_src<MODE>(F, path, b, hh, qb, (j_)); if (tm_.kpos0 >= 0) { \
    const unsigned db_ = (unsigned)(tm_.kpos0 - qpos + 4 * hi + 128);     \
    _Pragma("unroll") for (int r = 0; r < 16; ++r) { const unsigned c_ = (unsigned)((r & 3) + 8 * (r >> 2)); \
      if (db_ + c_ > 256u) P0[r] = -__builtin_inff(); if (db_ + c_ + 32u > 256u) P1[r] = -__builtin_inff(); } } } } while (0)
  f32x16 pA0, pA1, pB0, pB1; float alA, alB; bf16x8 pa0, pa1, pa2, pa3;
  int s_prev = 0, s_cur = SLOT, s_dma = 3 * SLOT;
#define ROT() do { s_prev = s_cur; s_cur = (s_cur + SLOT) & (4 * SLOT - 1); s_dma = (s_dma + SLOT) & (4 * SLOT - 1); } while (0)
#define STEP(PC0, PC1, ALC, PP0, PP1, ALP, j_) do { const bool more_ = (j_) + 2 < NT; if (more_) DMA_TILE((j_) + 2, s_dma); \
    SBAR(); qkt<KP>(PC0, PC1, lds + s_cur + VB, qr, r32, hi, kcb, negm); \
    finishSM(PP0, PP1, ALP, l_reg, pa0, pa1, pa2, pa3); SBAR(); \
    pv_all<ND>(o, vb0 + s_prev, pa0, pa1, pa2, pa3); MASK(PC0, PC1, (j_)); partialSM(PC0, PC1, mhat, negm, ALC); \
    RESC(ALC); if (more_) DMA_WAIT(1); else DMA_WAIT(0); __syncthreads(); ROT(); } while (0)
  DMA_TILE(0, 0); DMA_TILE(1, SLOT); DMA_TILE(2, 2 * SLOT);
  { const bf16* Qw = F.PROJ() + (qrow0 + r32) * LDP + qcol + hi * 8;
#pragma unroll
    for (int d0 = 0; d0 < 4; ++d0) qr[d0] = ld8(Qw + d0 * 16); }
  DMA_WAIT(1); __syncthreads();
  qkt<KP>(pA0, pA1, lds + VB, qr, r32, hi, kcb, negm); MASK(pA0, pA1, 0); partialSM(pA0, pA1, mhat, negm, alA);
  for (int j = 1; j + 1 < NT; j += 2) {
    STEP(pB0, pB1, alB, pA0, pA1, alA, j);
    STEP(pA0, pA1, alA, pB0, pB1, alB, j + 1);
  }
  SBAR(); qkt<KP>(pB0, pB1, lds + s_cur + VB, qr, r32, hi, kcb, negm);
  finishSM(pA0, pA1, alA, l_reg, pa0, pa1, pa2, pa3); SBAR();
  pv_all<ND>(o, vb0 + s_prev, pa0, pa1, pa2, pa3); MASK(pB0, pB1, NT - 1); partialSM(pB0, pB1, mhat, negm, alB);
  RESC(alB);
  finishSM(pB0, pB1, alB, l_reg, pa0, pa1, pa2, pa3); SBAR();
  pv_all<ND>(o, vb0 + s_cur, pa0, pa1, pa2, pa3);
#undef STEP
#undef ROT
#undef DMA_TILE
#undef DMA_WAIT
#undef RESC
#undef MASK
  if (MODE == 1) { const float sk = in_ptr(17)[layer * 4 + hh * 2 + wc]; l_reg += __builtin_amdgcn_exp2f(sk * 1.4426950408889634f - mhat); }
  if (hi == 0) li_l[r32] = l_reg; asm volatile("s_waitcnt lgkmcnt(0)" ::: "memory");
  float rli[16];
#pragma unroll
  for (int r = 0; r < 16; ++r) rli[r] = __builtin_amdgcn_rcpf(li_l[crow(r, hi)]);
  if (MODE == 0) {
    const float lam = F.ROPE()[2048 + layer * 2], omli = F.ROPE()[2048 + layer * 2 + 1];
    float* X = (float*)lds;
    __syncthreads();
    if (wc == 1) {
#pragma unroll
      for (int d = 0; d < 4; ++d)
#pragma unroll
        for (int r = 0; r < 16; ++r) X[((wq * 4 + d) * 16 + r) * 64 + lane] = o[d][r] * rli[r] * lam;
    }
    __syncthreads();
    if (wc == 0) {
      const float* dg = in_ptr(16) + layer * 128;
      float dgv[4];
#pragma unroll
      for (int d = 0; d < 4; ++d) dgv[d] = dg[32 * d + r32] * omli;
      unsigned short zv[16][4];
#pragma unroll
      for (int r = 0; r < 16; ++r) { const bf16* zr = F.PROJ() + (qrow0 + crow(r, hi)) * LDP + C_Z + hh * 128 + r32;
#pragma unroll
        for (int d = 0; d < 4; ++d) zv[r][d] = zr[32 * d]; }
#pragma unroll
      for (int r = 0; r < 16; ++r) {
        float v[4]; float ss = 0.f;
#pragma unroll
        for (int d = 0; d < 4; ++d) { v[d] = o[d][r] * rli[r] - X[((wq * 4 + d) * 16 + r) * 64 + lane]; ss += v[d] * v[d]; }
#pragma unroll
        for (int off = 1; off < 32; off <<= 1) ss += __shfl_xor(ss, off);
        const float rstd = 1.f / sqrtf(ss * (1.f / 128.f) + RMS_EPS);
        bf16* mr = F.PROJ() + (qrow0 + crow(r, hi)) * LDP + C_Z + hh * 128 + r32;
#pragma unroll
        for (int d = 0; d < 4; ++d) mr[32 * d] = (bf16)f2bf(v[d] * rstd * dgv[d] * bf2f(zv[r][d]));
      }
    }
    __syncthreads();
  } else {
    const int mc = 512 + (hh * 2 + wc) * 64 + r32;
    unsigned short zv[16][2];
#pragma unroll
    for (int r = 0; r < 16; ++r) { const bf16* zr = F.PROJ() + (qrow0 + crow(r, hi)) * LDP + C_Z + mc; zv[r][0] = zr[0]; zv[r][1] = zr[32]; }
#pragma unroll
    for (int r = 0; r < 16; ++r) {
      bf16* mr = F.PROJ() + (qrow0 + crow(r, hi)) * LDP + C_Z + mc;
#pragma unroll
      for (int d = 0; d < 2; ++d) mr[32 * d] = (bf16)f2bf(o[d][r] * rli[r] * bf2f(zv[r][d]));
    }
    __syncthreads();
  }
}

__device__ __forceinline__ void fourier_unit(const Frame& F, int path, int b, int kb, int cb, char* lds) {
  int tid_ = threadIdx.x; asm volatile("" : "+v"(tid_));
  const int tid = tid_, wid = __builtin_amdgcn_readfirstlane(tid >> 6), lane = tid & 63, r32 = lane & 31, hi = lane >> 5;
  char* V_lds = lds;
  const int S = path ? 2048 : 256, TPP = S / 64, NT = 2 * TPP;
  const long rowbase = path ? NCTX + (long)b * 2048 : (long)b * 256;
  const int k0 = kb * 256 + wid * 32;
  const bf16* Dm = F.DFTC() + (long)(k0 + r32) * (2 * S) + hi * 8;
  const int sr = tid >> 3, sc = (tid & 7) * 8;
  const int vst0 = v_st(sr, sc);
  const int vb0 = (int)(uintptr_t)V_lds + v_rd_base(lane);
  f32x16 o[2]; o[0] = f32x16{}; o[1] = f32x16{};
  bf16x8 a0, a1, a2, a3, n0, n1, n2, n3; n0 = n1 = n2 = n3 = bf16x8{};
#define FV_SRC(j_) (F.PROJ() + (rowbase + ((j_) % TPP) * 64 + sr) * LDP + C_VF + ((j_) / TPP) * 256 + cb * 64 + sc)
#define FA_LOAD(A0, A1, A2, A3, j_) do { const bf16* p_ = Dm + ((j_) / TPP) * S + ((j_) % TPP) * 64; A0 = ld8(p_); A1 = ld8(p_ + 16); A2 = ld8(p_ + 32); A3 = ld8(p_ + 48); } while (0)
  { bf16x8 vr[8];
#pragma unroll
    for (int j = 0; j < 8; ++j) vr[j] = ld8(FV_SRC(j));
    FA_LOAD(a0, a1, a2, a3, 0);
#pragma unroll
    for (int j = 0; j < 8; ++j) *(bf16x8*)(V_lds + j * SHM_V + vst0) = vr[j]; }
  __syncthreads();
#pragma unroll 2
  for (int j = 0; j < NT; ++j) {
    if (j + 1 < NT) FA_LOAD(n0, n1, n2, n3, j + 1);
    pv_one<0>(o[0], vb0 + j * SHM_V, a0, a1, a2, a3); pv_one<1>(o[1], vb0 + j * SHM_V, a0, a1, a2, a3);
    a0 = n0; a1 = n1; a2 = n2; a3 = n3;
  }
  __syncthreads();
#undef FV_SRC
#undef FA_LOAD
  { const int mc = 768 + cb * 64 + r32;
    unsigned short zv[16][2];
#pragma unroll
    for (int r = 0; r < 16; ++r) { const bf16* zr = F.PROJ() + (rowbase + k0 + crow(r, hi)) * LDP + C_Z + mc; zv[r][0] = zr[0]; zv[r][1] = zr[32]; }
#pragma unroll
    for (int r = 0; r < 16; ++r) { bf16* mr = F.PROJ() + (rowbase + k0 + crow(r, hi)) * LDP + C_Z + mc;
#pragma unroll
      for (int d = 0; d < 2; ++d) mr[32 * d] = (bf16)f2bf(o[d][r] * bf2f(zv[r][d])); } }
}

__device__ __forceinline__ void fft_unit(const Frame& F, int b, int cs, char* lds) {
  int tid_ = threadIdx.x; asm volatile("" : "+v"(tid_));
  const int tid = tid_, w = __builtin_amdgcn_readfirstlane(tid >> 6), lane = tid & 63, r32 = lane & 31, hi = lane >> 5;
  const long rowbase = NCTX + (long)b * 2048; const int col0 = cs * 8;
  const bf16* P = F.PROJ();
  bf16x8 a1[2][4], a2[2][8], zg[4];
  { bf16x8 v[8];
#pragma unroll
    for (int it = 0; it < 8; ++it) v[it] = ld8((const bf16*)(F.ws + WS_VFT) + ((size_t)(b * 32 + cs) * 4096 + it * 512 + tid) * 8);
    { const bf16* M1p = F.FM1() + r32 * 64 + hi * 8;
#pragma unroll
      for (int rh = 0; rh < 2; ++rh)
#pragma unroll
        for (int ks = 0; ks < 4; ++ks) a1[rh][ks] = ld8(M1p + rh * 32 * 64 + ks * 16); }
#pragma unroll
    for (int it = 0; it < 8; ++it) { const int q = it * 512 + tid, ri = q >> 11, s = q & 2047, s1 = s >> 6, s2 = s & 63;
      *(bf16x8*)(lds + (s2 >> 4) * 16384 + v_st(ri * 32 + s1, (s2 & 15) * 8)) = v[it]; } }
  __syncthreads();
#pragma unroll
  for (int it = 0; it < 4; ++it) zg[it] = ld8(P + (rowbase + it * 512 + tid) * LDP + C_Z + 768 + col0);
  { const bf16* M2p = F.FM2() + r32 * 128 + hi * 8;
#pragma unroll
    for (int rh = 0; rh < 2; ++rh)
#pragma unroll
      for (int ks = 0; ks < 8; ++ks) a2[rh][ks] = ld8(M2p + rh * 32 * 128 + ks * 16); }
  f32x16 o1[2][2];
  { const int vb = (int)(uintptr_t)lds + (w >> 1) * 16384 + (w & 1) * 1024 + v_rd_base(lane);
#pragma unroll
    for (int rh = 0; rh < 2; ++rh) { o1[rh][0] = f32x16{}; o1[rh][1] = f32x16{}; }
#pragma unroll
    for (int rh = 0; rh < 2; ++rh) { pv_one<0>(o1[rh][0], vb, a1[rh][0], a1[rh][1], a1[rh][2], a1[rh][3]); pv_one<1>(o1[rh][1], vb, a1[rh][0], a1[rh][1], a1[rh][2], a1[rh][3]); } }
  char* XB = lds + 65536;
  {
#pragma unroll
    for (int d = 0; d < 2; ++d) { const int s2 = 8 * w + d * 4 + (r32 >> 3), col = r32 & 7; const float s2f = (float)s2 * (1.f / 2048.f);
#pragma unroll
      for (int rq = 0; rq < 4; ++rq) { float yr[4], yi[4];
#pragma unroll
        for (int e = 0; e < 4; ++e) { const int r = 4 * rq + e, k1 = 8 * rq + 4 * hi + e; const float rev = (float)k1 * s2f;
          const float tc = __builtin_amdgcn_cosf(rev), tsn = __builtin_amdgcn_sinf(rev);
          const float xr = o1[0][d][r], xi = o1[1][d][r]; yr[e] = xr * tc + xi * tsn; yi[e] = xi * tc - xr * tsn; }
        const int off = (col >> 2) * 16384 + v_st(s2, (col & 3) * 32 + 8 * rq + 4 * hi);
        uint2 pr, pi; pr.x = cvtpk(yr[0], yr[1]); pr.y = cvtpk(yr[2], yr[3]); pi.x = cvtpk(yi[0], yi[1]); pi.y = cvtpk(yi[2], yi[3]);
        *(uint2*)(XB + off) = pr; *(uint2*)(XB + 2 * 16384 + off) = pi; } } }
  __syncthreads();
  f32x16 o2[2];
  { const int vre = (int)(uintptr_t)XB + (w >> 2) * 16384 + (w & 3) * 512 + v_rd_base(lane), vim = vre + 2 * 16384;
#pragma unroll
    for (int rh = 0; rh < 2; ++rh) { o2[rh] = f32x16{};
      pv_one<0>(o2[rh], vre, a2[rh][0], a2[rh][1], a2[rh][2], a2[rh][3]); pv_one<0>(o2[rh], vim, a2[rh][4], a2[rh][5], a2[rh][6], a2[rh][7]); } }
  float* OUTS = (float*)lds;
#pragma unroll
  for (int rh = 0; rh < 2; ++rh)
#pragma unroll
    for (int r = 0; r < 16; ++r) { const int k = r32 + 32 * (crow(r, hi) + 32 * rh); OUTS[k * 8 + w] = o2[rh][r] * 0.02209708691207961f; }
  __syncthreads();
#pragma unroll
  for (int it = 0; it < 4; ++it) { const int k = it * 512 + tid; const long row = rowbase + k;
    const bf16x8 z = zg[it];
    const f32x4 x0 = *(const f32x4*)(OUTS + k * 8), x1 = *(const f32x4*)(OUTS + k * 8 + 4);
    u32x4 o; o.x = cvtpk(x0.x * bf2f((unsigned short)z[0]), x0.y * bf2f((unsigned short)z[1])); o.y = cvtpk(x0.z * bf2f((unsigned short)z[2]), x0.w * bf2f((unsigned short)z[3]));
    o.z = cvtpk(x1.x * bf2f((unsigned short)z[4]), x1.y * bf2f((unsigned short)z[5])); o.w = cvtpk(x1.z * bf2f((unsigned short)z[6]), x1.w * bf2f((unsigned short)z[7]));
    *(u32x4*)(F.PROJ() + row * LDP + C_Z + 768 + col0) = o; }
  __syncthreads();
}
#undef KSWZ
#undef SBAR
}

__device__ __forceinline__ void phase_prologue(Frame& F) {
    const int G = F.G, bid = blockIdx.x, tid = F.tid;
    {
        LAS float* sc = (LAS float*)(F.lds + RING_OFF);
        LAS float* red = (LAS float*)(F.lds + RING_OFF + 12 * 1024 * 4);
        bool have = false;
        for (int job = bid; job < 192; job += G) {
            if (!have) { for (int i = tid; i < 9 * 1024; i += 512) { const int p = i >> 10, k = i & 1023; const float v = p == 0 ? in_ptr(7)[k] : in_ptr(6)[(p - 1) * 1024 + k]; sc[k * 12 + p] = silu_f(v); } have = true; }
            __syncthreads();
            const int l = job / 48, j0 = (job % 48) * 64, ks = tid >> 6, jj = tid & 63;
            float acc[9];
#pragma unroll
            for (int p = 0; p < 9; ++p) acc[p] = 0.f;
            const float* wp = in_ptr(8) + ((size_t)l * 1024 + ks * 128) * 3072 + j0 + jj;
            for (int k0 = 0; k0 < 128; k0 += 32) { float wl[32];
#pragma unroll
                for (int kk = 0; kk < 32; ++kk) wl[kk] = wp[(size_t)(k0 + kk) * 3072];
#pragma unroll
                for (int kk = 0; kk < 32; ++kk) { const LAS f32x4* sp = (const LAS f32x4*)(sc + (ks * 128 + k0 + kk) * 12); const f32x4 s0 = sp[0], s1 = sp[1], s2 = sp[2]; const float w = wl[kk];
                    acc[0] += s0.x * w; acc[1] += s0.y * w; acc[2] += s0.z * w; acc[3] += s0.w * w; acc[4] += s1.x * w; acc[5] += s1.y * w; acc[6] += s1.z * w; acc[7] += s1.w * w; acc[8] += s2.x * w; } }
#pragma unroll
            for (int p = 0; p < 9; ++p) red[(ks * 64 + jj) * 9 + p] = acc[p];
            __syncthreads();
            for (int i = tid; i < 64 * 9; i += 512) { const int j2 = i / 9, p = i % 9; float s = 0.f;
#pragma unroll
                for (int q = 0; q < 8; ++q) s += red[(q * 64 + j2) * 9 + p];
                F.MOD()[((size_t)l * 9 + p) * 3072 + j0 + j2] = s + in_ptr(9)[l * 3072 + j0 + j2]; }
        }
        __syncthreads();
    }
    const long gt = (long)bid * 512 + tid, NGT = (long)G * 512;
    for (long i = gt; i < 4 * 4 * 64 * 128; i += NGT) {
        const int n2 = (int)(i & 127), c = (int)((i >> 7) & 63), lg = (int)(i >> 13); const int ri = n2 >> 6, d = n2 & 63;
        const float* wf = in_ptr(18) + (size_t)lg * 4096 + d; float s = 0.f;
#pragma unroll 16
        for (int j = 0; j < 64; ++j) { const float rev = (float)((j * c) & 63) * (1.f / 64.f); const float t = ri ? -__builtin_amdgcn_sinf(rev) : __builtin_amdgcn_cosf(rev); s += t * wf[j * 64]; }
        F.GF()[i] = s * 0.125f;
    }
    for (long i = gt; i < 1024; i += NGT) { const int pos = (int)(i >> 4), fi = (int)(i & 15); const float inv = powf(10000.f, -(float)fi / 16.f); const float ang = (float)pos * inv; F.ROPE()[i] = cosf(ang); F.ROPE()[1024 + i] = sinf(ang); }
    if (gt < 4) { const int l = (int)gt; float s1 = 0.f, s2 = 0.f;
        for (int k = 0; k < 64; ++k) { s1 += in_ptr(12)[l * 64 + k] * in_ptr(13)[l * 64 + k]; s2 += in_ptr(14)[l * 64 + k] * in_ptr(15)[l * 64 + k]; }
        const float li = 0.8f - 0.6f * expf(-0.3f * (float)l);
        F.ROPE()[2048 + 2 * l] = expf(s1) - expf(s2) + li; F.ROPE()[2048 + 2 * l + 1] = 1.f - li; }
    for (long i = gt; i < 64 * 64; i += NGT) { const int rr = (int)(i >> 6), cc = (int)(i & 63); const int rip = rr >> 5, k1 = rr & 31, ri = cc >> 5, s1 = cc & 31;
        const float rev = (float)((k1 * s1) & 31) * (1.f / 32.f); const float cs = __builtin_amdgcn_cosf(rev), sn = __builtin_amdgcn_sinf(rev);
        F.FM1()[i] = (bf16)f2bf(rip == ri ? cs : (rip == 0 ? sn : -sn)); }
    for (long i = gt; i < 64 * 128; i += NGT) { const int k2 = (int)(i >> 7), cc = (int)(i & 127); const int s2 = cc & 63;
        const float rev = (float)((k2 * s2) & 63) * (1.f / 64.f); F.FM2()[i] = (bf16)f2bf(cc < 64 ? __builtin_amdgcn_cosf(rev) : __builtin_amdgcn_sinf(rev)); }
    for (long i = gt; i < 256L * 512 / 8; i += NGT) { const int k = (int)(i >> 6), c0 = (int)(i & 63) * 8; const int part = c0 >> 8; v4u o; unsigned short h[8];
#pragma unroll
        for (int e = 0; e < 8; ++e) { const int s = (c0 + e) & 255; const float rev = (float)((k * s) & 255) * (1.f / 256.f); const float t = part ? __builtin_amdgcn_sinf(rev) : __builtin_amdgcn_cosf(rev); h[e] = (unsigned short)f2bf(t * 0.0625f); }
        o.x = h[0] | ((unsigned)h[1] << 16); o.y = h[2] | ((unsigned)h[3] << 16); o.z = h[4] | ((unsigned)h[5] << 16); o.w = h[6] | ((unsigned)h[7] << 16);
        *(GAS v4u*)(F.DFTC() + i * 8) = o; }
}
__device__ __forceinline__ void weight_prep(Frame& F, int l, int gw, int NGW, int gt, int NGT, int pwave, int plane, int which = 7) {
    if (which & 5) {
        LAS float* scr = (LAS float*)(F.lds + RING_OFF + pwave * 16384);
        constexpr int I_IN = 16 * 104, I_OUT = 16 * 32, I_FOLD = 1024, NITEMS = I_FOLD + I_IN + I_OUT;
        const float* win_l = in_ptr(11) + (size_t)l * DM * NIN; const float* wout_l = in_ptr(19) + (size_t)l * DM * DM;
        for (int it = gw; it < NITEMS; it += NGW) {
            int r = it;
            if (r < I_FOLD) { if (which & 4) fold_item(win_l, F.GF() + (size_t)l * 4 * 64 * 128, F.WIN(l), scr, r, plane); continue; } r -= I_FOLD;
            if (!(which & 1)) break;
            if (r < I_IN) { const int nb = r % 104; if (nb >= 64 && nb < 72) continue; p0_transpose_item(win_l, DM, NIN, F.WIN(l), nb >= 72 ? 256 : 0, scr, r, plane); continue; } r -= I_IN;
            p0_transpose_item(wout_l, DM, DM, F.WOUT(l), 0, scr, r, plane);
        }
    }
    if (which & 2) {
        constexpr int NA = 8 * 256 * 512 / 8, NB = 8 * 256 * 128 / 8;
        for (int i = gt; i < 2 * NA + 2 * NB; i += NGT) {
            const float* src; bf16* dst;
            if (i < 2 * NA) { const bool isv = i >= NA; const int e = (isv ? i - NA : i) * 8; const int b = (int)(e >> 17), t = (int)(e >> 9) & 255, h = (int)(e >> 7) & 3, c8 = (int)e & 127;
                src = in_ptr(isv ? 3 : 2) + ((long)(b * 4 + l) << 17) + (e & 131071); dst = (bf16*)(F.ws + (isv ? WS_VAL : WS_KAL)) + ((size_t)(b * 4 + h) * 2304 + 2048 + t) * 128 + c8; }
            else { const int i2 = i - 2 * NA; const bool isv = i2 >= NB; const int e = (isv ? i2 - NB : i2) * 8; const int b = (int)(e >> 15), t = (int)(e >> 7) & 255, kvh = (int)(e >> 6) & 1, c8 = (int)e & 63;
                src = in_ptr(isv ? 5 : 4) + ((long)(b * 4 + l) << 15) + (e & 32767); dst = (bf16*)(F.ws + (isv ? WS_VBL : WS_KBL)) + ((size_t)(b * 2 + kvh) * 2304 + 2048 + t) * 64 + c8; }
            const f32x4 a = *(const f32x4*)src, c = *(const f32x4*)(src + 4);
            v4u o; o.x = pk2(a.x, a.y); o.y = pk2(a.z, a.w); o.z = pk2(c.x, c.y); o.w = pk2(c.z, c.w);
            *(GAS v4u*)dst = o;
        }
    }
}
__device__ __forceinline__ void stream_rows(Frame& F, int l, int r0, int w0, int wn) {
    int tid_ = threadIdx.x; asm volatile("" : "+v"(tid_));
    const int plane = tid_ & 63, pwave = __builtin_amdgcn_readfirstlane(tid_ >> 6);
    float* X = F.out;
    const float* ng = l == DEPTH ? in_ptr(20) : in_ptr(10) + l * DM;
    for (int i = pwave; i < wn; i += 2 * NWAVES) {
        const float* xprev[2]; const bf16* drow[2]; float* xw[2]; bf16* hn[2]; float* yrow[2]; const float* scale[2]; const float* shift[2];
#pragma unroll
        for (int r = 0; r < 2; ++r) {
            const int ii = i + r * NWAVES; const bool on = ii < wn; const int m = r0 + w0 + (on ? ii : i);
            const bool ctx = m < NCTX; const int p = ctx ? 0 : 1 + ((m - NCTX) >> 11);
            const float* xin = ctx ? in_ptr(0) + (size_t)m * DM : in_ptr(1) + (size_t)(m - NCTX) * DM;
            xprev[r] = on ? (l <= 1 ? xin : X + (size_t)m * DM) : nullptr;
            drow[r] = l == 0 ? nullptr : F.ACT() + (size_t)m * DM;
            xw[r] = (l == 0 || l == DEPTH) ? nullptr : X + (size_t)m * DM;
            hn[r] = F.ACT() + (size_t)m * DM; yrow[r] = X + (size_t)m * DM;
            const float* mp = F.MOD() + ((size_t)(l == DEPTH ? 0 : l) * 9 + p) * 3072; scale[r] = mp + 1024; shift[r] = mp;
        }
        if (l == DEPTH) stream_row<true, 2>(xprev, drow, xw, hn, yrow, ng, scale, shift, plane);
        else stream_row<false, 2>(xprev, drow, xw, hn, yrow, ng, scale, shift, plane);
    }
}
__device__ __forceinline__ void even_share(int n, int G_, int c, int& w0, int& wn) { int G = G_; asm volatile("" : "+s"(G));
    const int q = n / G, r = n % G; w0 = c * q + (c < r ? c : r); wn = q + (c < r ? 1 : 0); }
__device__ __forceinline__ void mix_list(Frame& F, int l, bool lat, char* lds) {
    int bid_ = blockIdx.x; asm volatile("" : "+s"(bid_));
    const int np = lat ? 1280 : 768;
    for (int p = bid_; p < np; p += F.G) {
        int type = -1, path = lat ? 1 : 0, b = 0, hh = 0, qb = 0;
        if (lat) {
            if (p < 512) { const int seg = p >> 8, within = p & 255, x = within & 7, li = within >> 3, idx = seg * 32 + li, j = idx >> 4, bh = x + 8 * j; type = 0; qb = idx & 15; b = bh >> 2; hh = bh & 3; }
            else if (p < 768) { const int u = p - 512, x = u & 7, li = u >> 3; type = 1; b = x; hh = li >> 4; qb = li & 15; }
            else if (p >= 896 && p < 1024) { const int u = p - 896; type = 3; b = u >> 5; hh = u & 31; }
            else if (p >= 1152) { const int u = p - 1152 + 128; type = 3; b = u >> 5; hh = u & 31; }
        } else {
            if (p < 256) { type = 0; b = p >> 3; hh = (p >> 1) & 3; qb = p & 1; }
            else if (p >= 384 && p < 512) { const int u = p - 384; type = 1; b = u >> 2; hh = (u >> 1) & 1; qb = u & 1; }
            else if (p >= 640) { const int u = p - 640; type = 2; b = u >> 2; hh = u & 3; }
        }
        if (type == 0) att::attn_unit<0>(F, l, path, b, hh, qb, lds);
        if (type == 1) att::attn_unit<1>(F, l, path, b, hh, qb, lds);
        if (type == 2) att::fourier_unit(F, 0, b, 0, hh, lds);
        if (type == 3) att::fft_unit(F, b, hh, lds);
    }
}
struct Args { const float* in[21]; float* out; unsigned char* ws; };
__global__ void __launch_bounds__(NWAVES * 64, 2) mk_fwd(Args args) {
    extern __shared__ __attribute__((aligned(16))) unsigned char lds[];
    Frame F;
    F.lds = (LAS unsigned char*)lds;
    F.tid = threadIdx.x; F.lane = F.tid & 63; F.wave = __builtin_amdgcn_readfirstlane(F.tid >> 6);
    F.G = gridDim.x;
    unsigned char* ws = args.ws;
    F.out = args.out; F.ws = ws;
    for (int u = F.tid; u < (LDS_BYTES - LDSCTL_OFF) / 4; u += NWAVES * 64) ((LAS unsigned*)(F.lds + LDSCTL_OFF))[u] = 0u;
    __syncthreads();
    (void)xcd_barrier_post((unsigned*)ws + CW_BAR, (volatile LAS unsigned*)(F.lds + MISC_OFF) + 8);
#ifdef PROBE_BAR2
#define GRID_BAR() do { GRID_BAR1(); GRID_BAR1(); } while (0)
#else
#define GRID_BAR() GRID_BAR1()
#endif
#define GRID_BAR1() do { XcdBarrier bar_; bar_.bar = (unsigned*)F.ws + CW_BAR; bar_.x = xb_xcc_id(); bar_.st = (volatile LAS unsigned*)(F.lds + MISC_OFF) + 8; xcd_barrier(bar_); } while (0)

#ifdef PROBE_T
    unsigned long long tacc_ = 0, t0_ = 0;
#define TSTART(id) do { if (PROBE_T == (id)) t0_ = rt(); } while (0)
#define TSTOP(id) do { if (PROBE_T == (id)) tacc_ += rt() - t0_; } while (0)
#define TSPIN() do { if (blockIdx.x == 0) { const unsigned long long ts_ = rt(); while (rt() - ts_ < tacc_) __builtin_amdgcn_s_sleep(8); } } while (0)
#else
#define TSTART(id) do {} while (0)
#define TSTOP(id) do {} while (0)
#define TSPIN() do {} while (0)
#endif
    const int G = F.G, c = (int)blockIdx.x, H = G / 2;
    char* ldsg = (char*)lds + RING_OFF;
    TSTART(1); phase_prologue(F);
    {
        int tid_ = threadIdx.x; asm volatile("" : "+v"(tid_)); const int plane = tid_ & 63, pwave = __builtin_amdgcn_readfirstlane(tid_ >> 6);
        weight_prep(F, 0, c * NWAVES + pwave, G * NWAVES, 0, 1, pwave, plane, 1);
    }
    GRID_BAR();
    {
        int tid_ = threadIdx.x; asm volatile("" : "+v"(tid_)); const int plane = tid_ & 63, pwave = __builtin_amdgcn_readfirstlane(tid_ >> 6);
        weight_prep(F, 0, c * NWAVES + pwave, G * NWAVES, c * 512 + tid_, G * 512, pwave, plane, 6);
        int w0, wn; even_share(NCTX, G, c, w0, wn); stream_rows(F, 0, 0, w0, wn);
    }
    GRID_BAR(); TSTOP(1);
    for (int s = 0; s < 4 * DEPTH; ++s) {
        const int l = s >> 2, ph = s & 3; const bool lat = (ph == 1 || ph == 3);
        const int pm0 = lat ? 32 : 0, rows = lat ? NLAT : NCTX;
        if (ph < 2) {
            TSTART(2 + ph);
            pg8::Gemm g{F.ACT(), F.WIN(l), rows, NPROJ, DM, DM}; pg8::StaticOrder S; S.init(rows, NPROJ, G, c, pm0);
            pg8::EpiInProj E{F.ws, F.out, l};
            pg8::gemm_phase<pg8::EpiInProj, pg8::StaticOrder, true, true>(F.lds + RING_OFF, g, S, E);
            if (ph == 0) {
                int w0, wn;
                if (G == 256) { if (c < 192) { w0 = c * 52; wn = 52; } else { w0 = 192 * 52 + (c - 192) * 100; wn = 100; } } else even_share(NLAT, G, c, w0, wn);
                stream_rows(F, l, NCTX, w0, wn);
            } else mix_list(F, l, false, ldsg);
            GRID_BAR(); TSTOP(2 + ph);
        } else {
            TSTART(2 + ph);
            pg8::Gemm g{F.PROJ() + C_Z, F.WOUT(l), rows, DM, DM, LDP}; pg8::StaticOrder S; S.init(rows, DM, G, c, pm0);
            pg8::EpiDelta E{F.ws, l};
            pg8::gemm_phase<pg8::EpiDelta, pg8::StaticOrder, true, true>(F.lds + RING_OFF, g, S, E);
            if (ph == 2) { mix_list(F, l, true, ldsg);
            } else {
                int w0, wn; even_share(NCTX, G, c, w0, wn); stream_rows(F, l + 1, 0, w0, wn);
                if (l + 1 < DEPTH) { int tid_ = threadIdx.x; asm volatile("" : "+v"(tid_)); const int plane = tid_ & 63, pwave = __builtin_amdgcn_readfirstlane(tid_ >> 6);
                    weight_prep(F, l + 1, c * NWAVES + pwave, G * NWAVES, c * 512 + tid_, G * 512, pwave, plane); }
            }
            GRID_BAR(); TSTOP(2 + ph);
        }
    }
    TSTART(6); { int w0, wn; even_share(NLAT, G, c, w0, wn); stream_rows(F, DEPTH, NCTX, w0, wn); } TSTOP(6);
    TSPIN();
#undef GRID_BAR
}

extern "C" void kernel_launch(void* const* d_in, const int* in_sizes, int n_in, void* d_out, int out_size, void* d_ws, size_t ws_size, hipStream_t stream) {
    static int grid = 0;
    if (grid == 0) {
        if (n_in != 21 || ws_size < WS_END) { fprintf(stderr, "kernel_launch: built for 21 inputs and >= %zu bytes of workspace; got n_in %d, ws %zu\n", (size_t)WS_END, n_in, ws_size); grid = -1; return; }
        int dev = 0, cus = 0, per_cu = 0;
        if (hipGetDevice(&dev) != hipSuccess || hipDeviceGetAttribute(&cus, hipDeviceAttributeMultiprocessorCount, dev) != hipSuccess) { grid = -1; return; }
        if (hipFuncSetAttribute((const void*)mk_fwd, hipFuncAttributeMaxDynamicSharedMemorySize, LDS_BYTES) != hipSuccess) { fprintf(stderr, "kernel_launch: hipFuncSetAttribute failed\n"); grid = -1; return; }
        if (hipOccupancyMaxActiveBlocksPerMultiprocessor(&per_cu, (const void*)mk_fwd, NWAVES * 64, LDS_BYTES) != hipSuccess || per_cu < 1) fprintf(stderr, "kernel_launch: occupancy query reports %d\n", per_cu);
        (void)hipGetLastError();
        grid = cus;
    }
    if (grid < 0) return;
    if (hipMemsetAsync((char*)d_ws + WS_CTL, 0, CTL_ZERO_BYTES, stream) != hipSuccess) return;
    Args a{};
    for (int i = 0; i < 21; ++i) a.in[i] = (const float*)d_in[i];
    a.out = (float*)d_out; a.ws = (unsigned char*)d_ws;
    hipLaunchKernelGGL(mk_fwd, dim3(grid), dim3(NWAVES * 64), LDS_BYTES, stream, a);
    const hipError_t le = hipPeekAtLastError();
    if (le != hipSuccess) fprintf(stderr, "kernel_launch: launch failed: %s\n", hipGetErrorName(le));
}
```

```cpp
#include <hip/hip_runtime.h>
#include <cstdio>
#include <cstdint>
#include <cmath>
constexpr int DM = 1024, NCTX = 8192, NLAT = 16384, MTOK = NCTX + NLAT, DEPTH = 4, LDP = 2304, NPROJ = 3584, NIN = 3328;
constexpr int C_QA = 0, C_QB = 512, C_VF = 768, C_Z = 1280;
constexpr int NWAVES = 8;
constexpr float RMS_EPS = 1e-6f;
constexpr float QSCALE = 0.125f * 1.4426950408889634f;
constexpr size_t MiB = 1u << 20;
constexpr size_t WS_CTL = 0, CTL_ZERO_BYTES = 64 * 1024;
constexpr size_t WS_MOD = 1 * MiB;
constexpr size_t WS_G = WS_MOD + MiB / 2;
constexpr size_t WS_ROPE = 2 * MiB;
constexpr size_t WS_DFTC = 2 * MiB + MiB / 4;
constexpr size_t WS_FM1 = 3 * MiB;
constexpr size_t WS_FM2 = WS_FM1 + 8192;
constexpr size_t WS_ROWSS = MiB / 2;
constexpr size_t WS_GS = 2 * MiB + 65536;
constexpr size_t WS_BIAS = 2 * MiB + MiB / 2;
constexpr size_t WS_WIN = 4 * MiB;
constexpr size_t WS_WOUT = 11 * MiB, WOUT_BYTES = 2 * MiB;
constexpr size_t WS_ACT = 15 * MiB;
constexpr size_t WS_PROJ = 63 * MiB;
constexpr size_t WS_KAL = 171 * MiB, WS_VAL = 189 * MiB;
constexpr size_t WS_KAC = 207 * MiB, WS_VAC = 215 * MiB;
constexpr size_t WS_KBL = 223 * MiB, WS_VBL = WS_KBL + 9 * MiB / 2;
constexpr size_t WS_KBC = 232 * MiB, WS_VBC = 234 * MiB;
constexpr size_t WS_VFT = 236 * MiB;
constexpr size_t WS_END = 252 * MiB;
static_assert(WS_PROJ + (size_t)MTOK * LDP * 2 <= WS_KAL && WS_ACT + (size_t)MTOK * DM * 2 <= WS_PROJ && WS_KAL + 8ull * 4 * 2304 * 128 * 2 <= WS_VAL && WS_KBL + 8ull * 2 * 2304 * 64 * 2 <= WS_VBL && WS_VBL + 8ull * 2 * 2304 * 64 * 2 <= WS_KBC && WS_VBC + 32ull * 2 * 256 * 64 * 2 <= WS_VFT && WS_VFT + 8ull * 32 * 2 * 2048 * 8 * 2 <= WS_END, "ws map");
static_assert(WS_WIN + (size_t)NPROJ * DM * 2 <= WS_WOUT && WS_WOUT + 2 * WOUT_BYTES <= WS_ACT, "ws map (weights)");
constexpr int CW_BAR = 4096;
constexpr int RING_OFF = 0, RING_BYTES = 131072;
constexpr int LDSCTL_OFF = RING_BYTES, MISC_OFF = LDSCTL_OFF + 320;
constexpr int ROPE_LDS_OFF = LDSCTL_OFF + 4096;
constexpr int LDS_BYTES = 147456;
static_assert(ROPE_LDS_OFF + 12288 <= LDS_BYTES && ROPE_LDS_OFF >= LDSCTL_OFF + 1024 + 8 * 256, "spare LDS: barrier words, the attention bodies' per-wave scratch, the RoPE table");

typedef const float* cfp_t;
typedef __attribute__((address_space(4))) const char* kaptr_t;
typedef __attribute__((address_space(4))) const cfp_t* kcfp_t;
__device__ __forceinline__ const float* in_ptr(int i) {
    kaptr_t ka = (kaptr_t)__builtin_amdgcn_kernarg_segment_ptr();
    asm volatile("" : "+s"(ka));
    return *(kcfp_t)(ka + 8 * i);
}
namespace pg8 {
#define PG8_LAS __attribute__((address_space(3)))
typedef unsigned short bf16_t;
typedef short bf16x8 __attribute__((ext_vector_type(8)));
typedef float f32x4 __attribute__((ext_vector_type(4)));
typedef unsigned u32x4 __attribute__((ext_vector_type(4)));
constexpr int BM = 256, BK = 64, HALF = 128, HTB = HALF * BK * 2  , STAGE_BYTES = 8 * HTB, NXCD = 8, WGM = 4;

__host__ __device__ __forceinline__ int lds_byte(int r, int c) { const int st = (r >> 4) * 2 + (c >> 5), rr = r & 15, cc = c & 31, ob = rr * 64 + cc * 2; return st * 1024 + (ob ^ (((ob >> 9) & 1) << 5)); }
__host__ __device__ __forceinline__ void stage_rc(int b, int& R, int& C) { const int st = b / 1024, sb = b % 1024, swz = sb ^ (((sb >> 9) & 1) << 5); R = (st >> 1) * 16 + swz / 64; C = (st & 1) * 32 + (swz % 64) / 2; }
__host__ __device__ __forceinline__ int perm32(int rho) { const int n = rho >> 4, i = rho & 15; return 8 * (i >> 2) + 4 * n + (i & 3); }

struct Unit { int pm, pn; };
struct Gemm { const bf16_t* A; const bf16_t* Bt; int M, N, K, lda; };

struct StaticOrder {
    int nM, nN, nwg, G, c, pm0;
    __host__ __device__ void init(int M, int N, int G_, int c_, int pm0_ = 0) { nM = M / BM; nN = N / BM; nwg = nM * nN; G = G_; c = c_; pm0 = pm0_; }
    __host__ __device__ bool next(int i, Unit& u) const {
        const long L = (long)i * G + c; if (L >= nwg) return false;
        int wgid = (int)L; { const int q = nwg / NXCD, r = nwg % NXCD, xcd = wgid % NXCD, off = wgid / NXCD; wgid = (xcd < r ? xcd * (q + 1) : r * (q + 1) + (xcd - r) * q) + off; }
        const int nig = WGM * nN, gid = wgid / nig, fm = gid * WGM, gsz = (nM - fm) < WGM ? (nM - fm) : WGM;
        u.pm = pm0 + fm + ((wgid % nig) % gsz); u.pn = (wgid % nig) / gsz; return true;
    }
    __device__ __forceinline__ void a_ready(const Unit&) const {}
    __device__ __forceinline__ void done(const Unit&) const {}
};

__device__ __forceinline__ unsigned cvt_pk_bf16(float lo, float hi) { unsigned r; asm volatile("v_cvt_pk_bf16_f32 %0, %1, %2" : "=v"(r) : "v"(lo), "v"(hi)); return r; }
struct EpiInProj {
    static constexpr bool PERM = true, AFTER_DRAIN = false;
    unsigned char* ws; float* out; int layer;
    __device__ __forceinline__ void operator()(const f32x4 (&acc)[2][2][4][2], const Unit& u, int wr, int wc, int fr_, int fq_) const {
        int fr = fr_, fq = fq_; asm volatile("" : "+v"(fr), "+v"(fq));
        const bool ctx = u.pm < 32;
        extern __shared__ __attribute__((aligned(16))) unsigned char lds_epi[];
        typedef __attribute__((address_space(3))) const float* lcf_t; typedef __attribute__((address_space(3))) const f32x4* lcf4_t;
        bf16_t* P = (bf16_t*)(ws + WS_PROJ); const lcf_t rcos = (lcf_t)(lds_epi + ROPE_LDS_OFF), rsin = rcos + 2048 - (fq >> 1) * 1024;
        float* o_dk = out + (size_t)MTOK * DM; float* o_dv = o_dk + 32L * 4 * 256 * 512; float* o_sk = o_dv + 32L * 4 * 256 * 512; float* o_sv = o_sk + 32L * 4 * 256 * 128;
#pragma unroll
        for (int bj = 0; bj < 2; ++bj) {
            const int colb = u.pn * 256 + bj * 128;
            const bool lperm = !(!ctx && colb >= 2048 && colb < 2560);
            const int ln = fq * 16 + fr, bsrc = ((((ln & 3) << 4) | (ln >> 2)) << 2);
            const int sfr = lperm ? (ln >> 2) : fr, sfq = lperm ? (ln & 3) : fq;
            const int col0 = colb + wc * 32 + 8 * sfq;
            const bool rope = !ctx && (colb < 1024 || (colb >= 1536 && colb < 1920));
            const bool silu = colb >= 2560;
            const int bb = ctx ? u.pm : (u.pm - 32) >> 3, s0 = ctx ? 0 : ((u.pm - 32) & 7) * 256, SL = ctx ? 256 : 2304;
            bf16_t* dbase; int dld;
            if (colb < 512) { dbase = P + (size_t)u.pm * 256 * LDP + col0; dld = LDP; }
            else if (colb < 1536) { const bool isv = colb >= 1024; const int h = ((colb - 512) >> 7) & 3;
                bf16_t* kv = (bf16_t*)(ws + (ctx ? (isv ? WS_VAC : WS_KAC) : (isv ? WS_VAL : WS_KAL)));
                dbase = kv + ((size_t)(bb * 4 + h) * SL + s0) * 128 + wc * 32 + 8 * sfq; dld = 128; }
            else if (colb < 1792) { dbase = P + (size_t)u.pm * 256 * LDP + C_QB + (col0 - 1536); dld = LDP; }
            else if (colb < 2048) { const bool isv = colb >= 1920; const int kvh = wc >> 1;
                bf16_t* kv = (bf16_t*)(ws + (ctx ? (isv ? WS_VBC : WS_KBC) : (isv ? WS_VBL : WS_KBL)));
                dbase = kv + ((size_t)(bb * 2 + kvh) * SL + s0) * 64 + (wc & 1) * 32 + 8 * sfq; dld = 64; }
            else if (colb < 2560) {
                if (ctx) { dbase = P + (size_t)u.pm * 256 * LDP + C_VF + (col0 - 2048); dld = LDP; }
                else { const int vc = col0 - 2048, cs = (vc & 255) >> 3, ri = vc >> 8;
                    dbase = (bf16_t*)(ws + WS_VFT) + ((size_t)((bb * 32 + cs) * 2 + ri) * 2048 + s0) * 8; dld = 8; } }
            else { dbase = P + (size_t)u.pm * 256 * LDP + C_Z + (col0 - 2560); dld = LDP; }
            float* fo = nullptr; int fld = 0, fcol = 0;
            if (ctx) {
                if (colb >= 512 && colb < 1024) { fo = o_dk; fld = 512; fcol = col0 - 512; }
                else if (colb >= 1024 && colb < 1536) { fo = o_dv; fld = 512; fcol = col0 - 1024; }
                else if (colb == 1792) { fo = o_sk; fld = 128; fcol = col0 - 1792; }
                else if (colb == 1920) { fo = o_sv; fld = 128; fcol = col0 - 1920; }
            }
            const int ti = 8 * (fq & 1);
            bf16_t* lb = dbase + (size_t)(wr * 64 + sfr) * dld;
            float* fb = fo ? fo + (size_t)((u.pm * 4 + layer) * 256 + wr * 64 + sfr) * fld + fcol : nullptr;
            asm volatile("" : "+v"(lb), "+v"(fb));
            const int tl = ti + ((wc & 1) ? fr * 16 : ((((u.pm - 32) & 7) * 4 + wr) * 16));
            const float qs = (colb < 512 || (colb >= 1536 && colb < 1792)) ? QSCALE : 1.f;
            u32x4 wp; bf16_t* wpp = lb;
#pragma unroll
            for (int ai = 0; ai < 2; ++ai)
#pragma unroll
                for (int m = 0; m < 4; ++m) {
                    const int ro = ai * 128 + m * 16;
                    f32x4 v0 = acc[ai][bj][m][0], v1 = acc[ai][bj][m][1];
                    if (rope) {
                        const int to = tl + ((wc & 1) ? m * 256 : ai * 32);
                        const f32x4 c0 = *(lcf4_t)(rcos + to), c1 = *(lcf4_t)(rcos + to + 4);
                        const f32x4 s0 = *(lcf4_t)(rsin + to), s1 = *(lcf4_t)(rsin + to + 4);
                        const f32x4 t0 = v0 * s0, t1 = v1 * s1; f32x4 p0, p1;
#pragma unroll
                        for (int e = 0; e < 4; ++e) {
                            float a0 = t0[e], a1 = t1[e];
                            asm volatile("s_nop 1\n\tv_permlane32_swap_b32 %0, %1\n\ts_nop 1\n\tv_permlane32_swap_b32 %1, %0" : "+v"(a0), "+v"(a1));
                            p0[e] = a1; p1[e] = a0; }
                        v0 = v0 * c0 + p0; v1 = v1 * c1 + p1;
                    }
                    v0 = v0 * qs; v1 = v1 * qs;
                    if (silu) {
#pragma unroll
                        for (int e = 0; e < 4; ++e) { v0[e] = v0[e] * __builtin_amdgcn_rcpf(1.f + __expf(-v0[e])); v1[e] = v1[e] * __builtin_amdgcn_rcpf(1.f + __expf(-v1[e])); }
                    }
                    u32x4 w; w.x = cvt_pk_bf16(v0[0], v0[1]); w.y = cvt_pk_bf16(v0[2], v0[3]); w.z = cvt_pk_bf16(v1[0], v1[1]); w.w = cvt_pk_bf16(v1[2], v1[3]);
                    if (ai + m > 0) *(__attribute__((address_space(1))) u32x4*)wpp = wp;
                    if (lperm) { w.x = __builtin_amdgcn_ds_bpermute(bsrc, w.x); w.y = __builtin_amdgcn_ds_bpermute(bsrc, w.y); w.z = __builtin_amdgcn_ds_bpermute(bsrc, w.z); w.w = __builtin_amdgcn_ds_bpermute(bsrc, w.w); }
                    wp = w; wpp = lb + (size_t)(ro * dld);
                    if (ai == 1 && m == 3) *(__attribute__((address_space(1))) u32x4*)wpp = wp;
                    if (fo) { float* dst = fb + (size_t)(ro * fld);
#pragma unroll
                        for (int e = 0; e < 4; ++e) { v0[e] = __builtin_bit_cast(float, __builtin_amdgcn_ds_bpermute(bsrc, __builtin_bit_cast(int, (float)v0[e]))); v1[e] = __builtin_bit_cast(float, __builtin_amdgcn_ds_bpermute(bsrc, __builtin_bit_cast(int, (float)v1[e]))); }
                        *(__attribute__((address_space(1))) f32x4*)dst = v0; *(__attribute__((address_space(1))) f32x4*)(dst + 4) = v1; }
                }
        }
    }
};
struct EpiDelta {
    static constexpr bool PERM = true, AFTER_DRAIN = false;
    unsigned char* ws; int layer;
    __device__ __forceinline__ void operator()(const f32x4 (&acc)[2][2][4][2], const Unit& u, int wr, int wc, int fr_, int fq_) const {
        int fr = fr_, fq = fq_; asm volatile("" : "+v"(fr), "+v"(fq));
        const bool ctx = u.pm < 32; const int p = ctx ? 0 : 1 + ((u.pm - 32) >> 3);
        const float* gate = (const float*)(ws + WS_MOD) + ((size_t)layer * 9 + p) * 3072 + 2048;
        bf16_t* D = (bf16_t*)(ws + WS_ACT);
        const int col0 = u.pn * 256 + wc * 32 + 8 * fq;
        const int ln = fq * 16 + fr, bsrc = ((((ln & 3) << 4) | (ln >> 2)) << 2);
        const int row0 = u.pm * 256 + wr * 64 + (ln >> 2), scol0 = u.pn * 256 + wc * 32 + 8 * (ln & 3);
        f32x4 gv[2][2];
#pragma unroll
        for (int bj = 0; bj < 2; ++bj)
#pragma unroll
            for (int n = 0; n < 2; ++n) gv[bj][n] = *(const f32x4*)(gate + col0 + bj * 128 + 4 * n);
#pragma unroll
        for (int ai = 0; ai < 2; ++ai)
#pragma unroll
            for (int m = 0; m < 4; ++m) { bf16_t* rowp = D + (size_t)(row0 + ai * 128 + m * 16) * DM + scol0;
#pragma unroll
                for (int bj = 0; bj < 2; ++bj) { const f32x4 v0 = acc[ai][bj][m][0] * gv[bj][0], v1 = acc[ai][bj][m][1] * gv[bj][1];
                    u32x4 w; w.x = cvt_pk_bf16(v0[0], v0[1]); w.y = cvt_pk_bf16(v0[2], v0[3]); w.z = cvt_pk_bf16(v1[0], v1[1]); w.w = cvt_pk_bf16(v1[2], v1[3]);
                    w.x = __builtin_amdgcn_ds_bpermute(bsrc, w.x); w.y = __builtin_amdgcn_ds_bpermute(bsrc, w.y); w.z = __builtin_amdgcn_ds_bpermute(bsrc, w.z); w.w = __builtin_amdgcn_ds_bpermute(bsrc, w.w);
                    *(u32x4*)(rowp + bj * 128) = w; } }
    }
};
template <class Epi, class Sched, bool ALIGN_EPI = false, bool SP2 = false>
__device__ __forceinline__ void gemm_phase(PG8_LAS unsigned char* lds, const Gemm g, const Sched& S, const Epi& E) {
    int tid_ = threadIdx.x; asm volatile("" : "+v"(tid_));
    const int tid = tid_, wid = __builtin_amdgcn_readfirstlane(tid >> 6), lane = tid & 63, wr = wid >> 2, wc = wid & 3, fr = lane & 15, fq = lane >> 4;
    const int K = g.K, nt = K / BK;
    unsigned voffA[2], voffB[2];
#pragma unroll
    for (int i = 0; i < 2; ++i) { int R, C; stage_rc(tid * 16 + i * 8192, R, C); const int Rb = Epi::PERM ? ((R & ~31) + perm32(R & 31)) : R;
        voffA[i] = (unsigned)(R * g.lda + C) * 2u; voffB[i] = (unsigned)(Rb * K + C) * 2u; }
    const size_t kstep = (size_t)(BK * 2);
    const size_t hstep = (size_t)HALF * K * 2;
    const size_t tstep = 2 * hstep;
    const size_t hstepA = (size_t)HALF * g.lda * 2, tstepA = 2 * hstepA;
    const unsigned ldsw = (unsigned)wid * 1024u;
    const int aoff = lds_byte(wr * 64 + fr, fq * 8), boff = lds_byte(wc * 32 + fr, fq * 8);
#define PG8_SA(b, h) (((b) * 2 + (h)) * HTB)
#define PG8_SB(b, h) ((4 + (b) * 2 + (h)) * HTB)
#define PG8_STAGE(bufoff, gbase, voff) do { _Pragma("unroll") for (int _i = 0; _i < 2; ++_i) \
        __builtin_amdgcn_global_load_lds((const unsigned*)((const char*)(gbase) + (voff)[_i]), (PG8_LAS unsigned*)(lds + (bufoff) + ldsw + _i * 8192), 16, 0, 0); } while (0)
#define PG8_LDA(dst, b, h) do { _Pragma("unroll") for (int m = 0; m < 4; ++m) _Pragma("unroll") for (int k = 0; k < 2; ++k) dst[m][k] = *(const PG8_LAS bf16x8*)(lds + PG8_SA(b, h) + aoff + m * 2048 + k * 1024); } while (0)
#define PG8_LDB(dst, b, h) do { _Pragma("unroll") for (int n = 0; n < 2; ++n) _Pragma("unroll") for (int k = 0; k < 2; ++k) dst[n][k] = *(const PG8_LAS bf16x8*)(lds + PG8_SB(b, h) + boff + n * 2048 + k * 1024); } while (0)
#define PG8_MMA(ai, bj, At, Bt) do { __builtin_amdgcn_s_setprio(1); _Pragma("unroll") for (int m = 0; m < 4; ++m) _Pragma("unroll") for (int n = 0; n < 2; ++n) _Pragma("unroll") for (int k = 0; k < 2; ++k) \
        acc[ai][bj][m][n] = __builtin_amdgcn_mfma_f32_16x16x32_bf16(Bt[n][k], At[m][k], acc[ai][bj][m][n], 0, 0, 0); __builtin_amdgcn_s_setprio(0); } while (0)
#define PG8_WAIT_V(n) asm volatile("s_waitcnt vmcnt(" #n ")" ::: "memory")
#define PG8_WAIT_L(n) asm volatile("s_waitcnt lgkmcnt(" #n ")" ::: "memory")
#define PG8_BAR __builtin_amdgcn_s_barrier()
#define PG8_SCHED __builtin_amdgcn_sched_barrier(0)
    Unit cur, nxt; int ui = 0;
    if (!S.next(0, cur)) return;
    f32x4 acc[2][2][4][2];
#pragma unroll
    for (int a = 0; a < 2; ++a)
#pragma unroll
        for (int b = 0; b < 2; ++b)
#pragma unroll
            for (int m = 0; m < 4; ++m)
#pragma unroll
                for (int n = 0; n < 2; ++n) acc[a][b][m][n] = (f32x4){0.f, 0.f, 0.f, 0.f};
    bf16x8 At[4][2], B0[2][2], B1[2][2];
    const char* cA = (const char*)g.A + (size_t)cur.pm * tstepA; const char* cB = (const char*)g.Bt + (size_t)cur.pn * tstep;
    S.a_ready(cur);
    if constexpr (SP2) {
        PG8_STAGE(PG8_SB(0, 0), cB, voffB); PG8_STAGE(PG8_SB(0, 1), cB + hstep, voffB); PG8_STAGE(PG8_SA(0, 0), cA, voffA); PG8_STAGE(PG8_SA(0, 1), cA + hstepA, voffA);
        if (wr == 1) PG8_BAR;
        PG8_WAIT_V(2); PG8_BAR;
        PG8_STAGE(PG8_SB(1, 0), cB + kstep, voffB); PG8_STAGE(PG8_SA(1, 0), cA + kstep, voffA); PG8_STAGE(PG8_SB(1, 1), cB + hstep + kstep, voffB);
        PG8_WAIT_V(6); PG8_BAR;
    } else {
        PG8_STAGE(PG8_SB(0, 0), cB, voffB); PG8_STAGE(PG8_SA(0, 0), cA, voffA); PG8_STAGE(PG8_SB(0, 1), cB + hstep, voffB); PG8_STAGE(PG8_SA(0, 1), cA + hstepA, voffA);
        if (wr == 1) PG8_BAR;
        PG8_WAIT_V(4); PG8_BAR;
        PG8_STAGE(PG8_SB(1, 0), cB + kstep, voffB); PG8_STAGE(PG8_SA(1, 0), cA + kstep, voffA); PG8_STAGE(PG8_SB(1, 1), cB + hstep + kstep, voffB);
        PG8_WAIT_V(6); PG8_BAR;
    }
    for (;;) {
        const bool has_next = S.next(ui + 1, nxt);
        const char* nA = has_next ? (const char*)g.A + (size_t)nxt.pm * tstepA : cA; const char* nB = has_next ? (const char*)g.Bt + (size_t)nxt.pn * tstep : cB;
        for (int t = 0; t < nt; t += 2) {
            const bool last = (t == nt - 2);
            const char* a1 = cA + (size_t)(t + 1) * kstep;
            const char* a2 = last ? nA : cA + (size_t)(t + 2) * kstep; const char* b2 = last ? nB : cB + (size_t)(t + 2) * kstep;
            const char* a3 = a2 + kstep; const char* b3 = b2 + kstep;
            if (last && has_next) S.a_ready(nxt);
            if constexpr (SP2) {
            PG8_LDB(B0, 0, 0); PG8_LDB(B1, 0, 1); PG8_SCHED; PG8_LDA(At, 0, 0); PG8_STAGE(PG8_SA(1, 1), a1 + hstepA, voffA);
            PG8_WAIT_V(8); PG8_WAIT_L(0); PG8_BAR; PG8_MMA(0, 0, At, B0); PG8_MMA(0, 1, At, B1); PG8_BAR; PG8_SCHED;
            PG8_LDA(At, 0, 1); PG8_STAGE(PG8_SB(0, 0), b2, voffB); PG8_STAGE(PG8_SB(0, 1), b2 + hstep, voffB); PG8_STAGE(PG8_SA(0, 0), a2, voffA);
            PG8_WAIT_V(8); PG8_WAIT_L(0); PG8_BAR; PG8_MMA(1, 0, At, B0); PG8_MMA(1, 1, At, B1); PG8_BAR; PG8_SCHED;
            PG8_LDB(B0, 1, 0); PG8_LDB(B1, 1, 1); PG8_SCHED; PG8_LDA(At, 1, 0); PG8_STAGE(PG8_SA(0, 1), a2 + hstepA, voffA);
            PG8_WAIT_V(8); PG8_WAIT_L(0); PG8_BAR; PG8_MMA(0, 0, At, B0); PG8_MMA(0, 1, At, B1); PG8_BAR; PG8_SCHED;
            PG8_LDA(At, 1, 1); PG8_STAGE(PG8_SB(1, 0), b3, voffB); PG8_STAGE(PG8_SB(1, 1), b3 + hstep, voffB); PG8_STAGE(PG8_SA(1, 0), a3, voffA);
            PG8_WAIT_V(8); PG8_WAIT_L(0); PG8_BAR; PG8_MMA(1, 0, At, B0); PG8_MMA(1, 1, At, B1); PG8_BAR; PG8_SCHED;
            } else {
            PG8_LDB(B0, 0, 0); PG8_SCHED; PG8_LDA(At, 0, 0); PG8_STAGE(PG8_SA(1, 1), a1 + hstepA, voffA);
            PG8_WAIT_L(8); PG8_BAR; PG8_WAIT_L(0); PG8_MMA(0, 0, At, B0); PG8_BAR; PG8_SCHED;
            PG8_LDB(B1, 0, 1); PG8_STAGE(PG8_SB(0, 0), b2, voffB);
            PG8_BAR; PG8_WAIT_L(0); PG8_MMA(0, 1, At, B1); PG8_BAR;
            PG8_LDA(At, 0, 1); PG8_STAGE(PG8_SA(0, 0), a2, voffA);
            PG8_BAR; PG8_WAIT_L(0); PG8_MMA(1, 0, At, B0); PG8_BAR; PG8_SCHED;
            PG8_STAGE(PG8_SB(0, 1), b2 + hstep, voffB);
            PG8_WAIT_V(6); PG8_BAR; PG8_MMA(1, 1, At, B1); PG8_BAR;
            PG8_LDB(B0, 1, 0); PG8_SCHED; PG8_LDA(At, 1, 0); PG8_STAGE(PG8_SA(0, 1), a2 + hstepA, voffA);
            PG8_WAIT_L(8); PG8_BAR; PG8_WAIT_L(0); PG8_MMA(0, 0, At, B0); PG8_BAR; PG8_SCHED;
            PG8_LDB(B1, 1, 1); PG8_STAGE(PG8_SB(1, 0), b3, voffB);
            PG8_BAR; PG8_WAIT_L(0); PG8_MMA(0, 1, At, B1); PG8_BAR;
            PG8_LDA(At, 1, 1); PG8_STAGE(PG8_SA(1, 0), a3, voffA);
            PG8_BAR; PG8_WAIT_L(0); PG8_MMA(1, 0, At, B0); PG8_BAR; PG8_SCHED;
            PG8_STAGE(PG8_SB(1, 1), b3 + hstep, voffB);
            PG8_WAIT_V(6); PG8_BAR; PG8_MMA(1, 1, At, B1); PG8_BAR;
            }
        }
        if constexpr (ALIGN_EPI) { if (wr == 0) PG8_BAR; }
        if constexpr (!Epi::AFTER_DRAIN) { E(acc, cur, wr, wc, fr, fq); S.done(cur); }
        if (!has_next) break;
#pragma unroll
        for (int a = 0; a < 2; ++a)
#pragma unroll
            for (int b = 0; b < 2; ++b)
#pragma unroll
                for (int m = 0; m < 4; ++m)
#pragma unroll
                    for (int n = 0; n < 2; ++n) acc[a][b][m][n] = (f32x4){0.f, 0.f, 0.f, 0.f};
        cur = nxt; cA = nA; cB = nB; ++ui;
        if constexpr (ALIGN_EPI) { if (wr == 1) PG8_BAR; }
    }
    PG8_WAIT_V(0);
    if constexpr (!ALIGN_EPI) { if (wr == 0) PG8_BAR; }
    PG8_BAR;
    if constexpr (Epi::AFTER_DRAIN) { E.fused(acc, cur, wr, wc, fr, fq, lds, wid, lane); S.done(cur); }
#undef PG8_SA
#undef PG8_SB
#undef PG8_STAGE
#undef PG8_LDA
#undef PG8_LDB
#undef PG8_MMA
#undef PG8_WAIT_V
#undef PG8_WAIT_L
#undef PG8_BAR
#undef PG8_SCHED
}
}
#define GAS __attribute__((address_space(1)))
#define LAS __attribute__((address_space(3)))
typedef unsigned short bf16;
typedef unsigned v4u __attribute__((ext_vector_type(4)));
typedef float f32x4 __attribute__((ext_vector_type(4)));
typedef short bf16x8 __attribute__((ext_vector_type(8)));
typedef GAS unsigned gu32;
typedef GAS unsigned long long gu64;
#define RLX_AGENT __ATOMIC_RELAXED, __HIP_MEMORY_SCOPE_AGENT
#define LDS_WAIT() asm volatile("s_waitcnt lgkmcnt(0)" ::: "memory")
#define VM_WAIT() asm volatile("s_waitcnt vmcnt(0)" ::: "memory")
__device__ __forceinline__ unsigned long long rt() { return __builtin_amdgcn_s_memrealtime(); }
__device__ __forceinline__ unsigned f2bf(float f) { unsigned u = __builtin_bit_cast(unsigned, f); return (u + 0x7fffu + ((u >> 16) & 1u)) >> 16; }
__device__ __forceinline__ unsigned pk2(float lo, float hi) { return f2bf(lo) | (f2bf(hi) << 16); }

#define XB_TMO      128
#define XB_XCNT(j)  (256  + 64 * (j))
#define XB_XSUB(j)  (1280 + 64 * (j))
#define XB_XGEN(j)  (2304 + 64 * (j))
#define XB_TOP      3328
#define XB_TOPGEN   3392
#define XCD_BAR_WORDS 3456
#define XB_SPIN_CAP (1u << 18)

__device__ __forceinline__ unsigned xb_ld(unsigned* p)              { return __hip_atomic_load(p, __ATOMIC_RELAXED, __HIP_MEMORY_SCOPE_AGENT); }
__device__ __forceinline__ unsigned xb_add(unsigned* p, unsigned v) { return __hip_atomic_fetch_add(p, v, __ATOMIC_RELAXED, __HIP_MEMORY_SCOPE_AGENT); }
__device__ __forceinline__ unsigned xb_xcc_id() { return (unsigned)__builtin_amdgcn_s_getreg((3 << 11) | 20) & 0xFu; }
#define XB_SPIN(cond, bar) do { unsigned _sp = 0; while (cond) { __builtin_amdgcn_s_sleep(1); \
    if ((++_sp & 255u) == 0u) { if (xb_ld(&(bar)[XB_TMO])) break; if (_sp > XB_SPIN_CAP) { atomicAdd(&(bar)[XB_TMO], 1u); break; } } } } while (0)

struct XcdBarrier {
    unsigned* bar; unsigned x;
    volatile LAS unsigned* st;
};

__device__ __forceinline__ XcdBarrier xcd_barrier_post(unsigned* bar, volatile LAS unsigned* st) {
    XcdBarrier b; b.bar = bar; b.x = xb_xcc_id(); b.st = st;
    if (threadIdx.x == 0) (void)xb_add(&bar[XB_XCNT(b.x)], 1u);
    return b;
}
__device__ __forceinline__ void xcd_barrier_complete(unsigned* bar, unsigned x, unsigned& nloc, unsigned& nx) {
    const unsigned G = gridDim.x * gridDim.y * gridDim.z;
    unsigned sum, cnt, mine, sp = 0u;
    for (;;) {
        sum = 0u; cnt = 0u; mine = 0u;
#pragma unroll
        for (unsigned j = 0; j < 16; ++j) { const unsigned c = xb_ld(&bar[XB_XCNT(j)]); sum += c; cnt += (c > 0u) ? 1u : 0u; mine = (j == x) ? c : mine; }
        if (sum == G) break;
        __builtin_amdgcn_s_sleep(1);
        if ((++sp & 255u) == 0u) { if (xb_ld(&bar[XB_TMO])) break; if (sp > XB_SPIN_CAP) { atomicAdd(&bar[XB_TMO], 1u); break; } }
    }
    nloc = mine > 0u ? mine : 1u; nx = cnt > 0u ? cnt : 1u;
}

__device__ __forceinline__ void xcd_barrier(const XcdBarrier& b) {
    asm volatile("s_waitcnt vmcnt(0)" ::: "memory");
    __syncthreads();
    if (threadIdx.x == 0) {
        unsigned* bar = b.bar;
        __builtin_amdgcn_s_waitcnt(0);
        unsigned nloc = b.st[0], nx = b.st[1];
        if (nloc == 0u) { xcd_barrier_complete(bar, b.x, nloc, nx); b.st[0] = nloc; b.st[1] = nx; }
        const unsigned old = xb_add(&bar[XB_XSUB(b.x)], 1u);
        const unsigned gen = old / nloc;
        if (old + 1u == (gen + 1u) * nloc) {
            __builtin_amdgcn_fence(__ATOMIC_RELEASE, "agent");
            asm volatile("s_waitcnt vmcnt(0)" ::: "memory");
            const unsigned og = xb_add(&bar[XB_TOP], 1u);
            const unsigned tg = og / nx;
            if (og + 1u == (tg + 1u) * nx) xb_add(&bar[XB_TOPGEN], 1u);
            else XB_SPIN(xb_ld(&bar[XB_TOPGEN]) == tg, bar);
            __builtin_amdgcn_fence(__ATOMIC_ACQUIRE, "agent");
            xb_add(&bar[XB_XGEN(b.x)], 1u);
            asm volatile("s_waitcnt vmcnt(0)" ::: "memory");
        } else {
            XB_SPIN(xb_ld(&bar[XB_XGEN(b.x)]) == gen, bar);
            __builtin_amdgcn_fence(__ATOMIC_ACQUIRE, "agent");
            asm volatile("s_waitcnt vmcnt(0)" ::: "memory");
        }
    }
    __syncthreads();
}

struct Frame {
    LAS unsigned char* lds;
    int tid, lane, wave, G;
    float* out;
    unsigned char* ws;
    __device__ __forceinline__ float* MOD() const { return (float*)(ws + WS_MOD); }
    __device__ __forceinline__ float* GF() const { return (float*)(ws + WS_G); }
    __device__ __forceinline__ float* ROPE() const { return (float*)(ws + WS_ROPE); }
    __device__ __forceinline__ bf16* DFTC() const { return (bf16*)(ws + WS_DFTC); }
    __device__ __forceinline__ bf16* FM1() const { return (bf16*)(ws + WS_FM1); }
    __device__ __forceinline__ bf16* FM2() const { return (bf16*)(ws + WS_FM2); }
    __device__ __forceinline__ bf16* WIN(int) const { return (bf16*)(ws + WS_WIN); }
    __device__ __forceinline__ bf16* WOUT(int l) const { return (bf16*)(ws + WS_WOUT + (size_t)(l & 1) * WOUT_BYTES); }
    __device__ __forceinline__ float* GS() const { return (float*)(ws + WS_GS); }
    __device__ __forceinline__ float* BIAS() const { return (float*)(ws + WS_BIAS); }
    __device__ __forceinline__ float* ROWSS() const { return (float*)(ws + WS_ROWSS); }
    __device__ __forceinline__ bf16* ACT() const { return (bf16*)(ws + WS_ACT); }
    __device__ __forceinline__ bf16* PROJ() const { return (bf16*)(ws + WS_PROJ); }
};
__device__ __forceinline__ float wave_sum(float v) {
#pragma unroll
    for (int o = 1; o < 64; o <<= 1) v += __shfl_xor(v, o);
    return v;
}
__device__ __forceinline__ float bf2f(unsigned short h) { return __builtin_bit_cast(float, (unsigned)h << 16); }
__device__ __forceinline__ float silu_f(float v) { return v / (1.f + __expf(-v)); }

__device__ __forceinline__ void p0_transpose_item(const float* W, int K, int N, bf16* WT, int row_off, LAS float* scr, int item, int lane, float sc = 1.f) {
    const int nblk = N / 32, kb = item / nblk, nb = item % nblk, k0 = 64 * kb, n0 = 32 * nb;
    float wl[32];
#pragma unroll
    for (int i = 0; i < 32; ++i) { const int kk = 2 * i + (lane >> 5); wl[i] = W[(size_t)(k0 + kk) * N + n0 + (lane & 31)]; }
#pragma unroll
    for (int i = 0; i < 32; ++i) { const int kk = 2 * i + (lane >> 5); scr[kk * 33 + (lane & 31)] = wl[i]; }
    LDS_WAIT(); asm volatile("" ::: "memory");
    const int c = lane & 7;
#pragma unroll
    for (int j = 0; j < 4; ++j) { const int n = (lane >> 3) + 8 * j; const LAS float* s = scr + (8 * c) * 33 + n;
        v4u o; o.x = pk2(s[0 * 33] * sc, s[1 * 33] * sc); o.y = pk2(s[2 * 33] * sc, s[3 * 33] * sc); o.z = pk2(s[4 * 33] * sc, s[5 * 33] * sc); o.w = pk2(s[6 * 33] * sc, s[7 * 33] * sc);
        *(GAS v4u*)(WT + (size_t)(row_off + n0 + n) * K + k0 + 8 * c) = o; }
    LDS_WAIT(); asm volatile("" ::: "memory");
}
__device__ __forceinline__ void fold_item(const float* win_l, const float* G_l, bf16* WinT, LAS float* scr, int item, int lane) {
    const int kb = item >> 6, g = (item >> 4) & 3, nb = item & 15;
    const int k = kb * 64 + lane;
    const f32x4* src = (const f32x4*)(win_l + (size_t)k * NIN + 2048 + g * 64);
    const float* Gg = G_l + g * 64 * 128 + nb * 8;
    f32x4 wv[16];
#pragma unroll
    for (int i = 0; i < 16; ++i) wv[i] = src[i];
    { const f32x4 g0 = *(const f32x4*)(Gg + lane * 128), g1 = *(const f32x4*)(Gg + lane * 128 + 4);
      *(LAS f32x4*)(scr + lane * 8) = g0; *(LAS f32x4*)(scr + lane * 8 + 4) = g1; }
    LDS_WAIT(); asm volatile("" ::: "memory");
    float a[8];
#pragma unroll
    for (int nn = 0; nn < 8; ++nn) a[nn] = 0.f;
#pragma unroll
    for (int i = 0; i < 16; ++i)
#pragma unroll
        for (int e = 0; e < 4; ++e) { const float w = wv[i][e]; const int c = 4 * i + e;
            const f32x4 g0 = *(const LAS f32x4*)(scr + c * 8), g1 = *(const LAS f32x4*)(scr + c * 8 + 4);
            a[0] += w * g0.x; a[1] += w * g0.y; a[2] += w * g0.z; a[3] += w * g0.w; a[4] += w * g1.x; a[5] += w * g1.y; a[6] += w * g1.z; a[7] += w * g1.w; }
    LDS_WAIT(); asm volatile("" ::: "memory");
#pragma unroll
    for (int nn = 0; nn < 8; ++nn) { const int n2 = nb * 8 + nn; const int ri = n2 >> 6, d = n2 & 63; const int nrow = 2048 + ri * 256 + g * 64 + d;
        WinT[(size_t)nrow * 1024 + k] = (bf16)f2bf(a[nn]); }
}
template <bool FINAL, int NR>
__device__ __forceinline__ void stream_row(const float* const (&xprev)[NR], const bf16* const (&drow)[NR], float* const (&xw)[NR], bf16* const (&hn)[NR], float* const (&yrow)[NR],
                                           const float* g, const float* const (&modp)[NR], const int (&pr)[NR], int& pc, f32x4 (&av)[4], f32x4 (&sv)[4], int lane, bool xbf) {
    f32x4 v[NR][4]; unsigned long long dd[NR][4]; float s[NR];
#pragma unroll
    for (int r = 0; r < NR; ++r) if (xprev[r]) {
        if (xbf) {
#pragma unroll
            for (int j = 0; j < 4; ++j) { const unsigned long long q = *(const GAS unsigned long long*)((const bf16*)xprev[r] + 4 * (lane + 64 * j));
                v[r][j].x = bf2f((unsigned short)q); v[r][j].y = bf2f((unsigned short)(q >> 16)); v[r][j].z = bf2f((unsigned short)(q >> 32)); v[r][j].w = bf2f((unsigned short)(q >> 48)); }
        } else {
#pragma unroll
            for (int j = 0; j < 4; ++j) v[r][j] = ((const GAS f32x4*)xprev[r] + lane)[64 * j];
        }
        if (drow[r]) {
#pragma unroll
            for (int j = 0; j < 4; ++j) dd[r][j] = *(const GAS unsigned long long*)(drow[r] + 4 * (lane + 64 * j)); }
    }
#pragma unroll
    for (int r = 0; r < NR; ++r) if (xprev[r]) {
        if (drow[r]) {
#pragma unroll
            for (int j = 0; j < 4; ++j) { const unsigned long long d = dd[r][j];
                v[r][j].x += bf2f((unsigned short)d); v[r][j].y += bf2f((unsigned short)(d >> 16)); v[r][j].z += bf2f((unsigned short)(d >> 32)); v[r][j].w += bf2f((unsigned short)(d >> 48)); }
        }
        float t = 0.f;
#pragma unroll
        for (int j = 0; j < 4; ++j) t += (v[r][j].x * v[r][j].x + v[r][j].y * v[r][j].y) + (v[r][j].z * v[r][j].z + v[r][j].w * v[r][j].w);
        s[r] = t;
    }
    float rstd[NR];
#pragma unroll
    for (int r = 0; r < NR; ++r) rstd[r] = xprev[r] ? 1.f / sqrtf(wave_sum(s[r]) * (1.f / DM) + RMS_EPS) : 0.f;
#pragma unroll
    for (int r = 0; r < NR; ++r) if (xprev[r]) {
        if (pr[r] != pc) { pc = pr[r];
#pragma unroll
            for (int j = 0; j < 4; ++j) { const int k = 4 * (lane + 64 * j); const f32x4 gj = *(const f32x4*)(g + k);
                if (FINAL) av[j] = gj; else { av[j] = gj * (*(const f32x4*)(modp[r] + 1024 + k) + 1.f); sv[j] = *(const f32x4*)(modp[r] + k); } } }
        if (xw[r]) {
#pragma unroll
            for (int j = 0; j < 4; ++j) *(GAS unsigned long long*)((bf16*)xw[r] + 4 * (lane + 64 * j)) = (unsigned long long)pk2(v[r][j].x, v[r][j].y) | ((unsigned long long)pk2(v[r][j].z, v[r][j].w) << 32);
        }
#pragma unroll
        for (int j = 0; j < 4; ++j) {
            const int k = 4 * (lane + 64 * j);
            if (FINAL) { *(f32x4*)(yrow[r] + k) = v[r][j] * rstd[r] * av[j]; }
            else {
                const f32x4 h = (v[r][j] * rstd[r]) * av[j] + sv[j];
                *(GAS unsigned long long*)(hn[r] + k) = (unsigned long long)pk2(h.x, h.y) | ((unsigned long long)pk2(h.z, h.w) << 32);
            }
        }
    }
}

namespace att {
using bf16x8 = __attribute__((ext_vector_type(8))) short;
using s16x4 = __attribute__((ext_vector_type(4))) short;
using f32x16 = __attribute__((ext_vector_type(16))) float;
using u32x4 = __attribute__((ext_vector_type(4))) unsigned;
constexpr int QBLK = 32, KVBLK = 64;
constexpr float SCALE = 0.125f;
constexpr float THR = 8.f;
constexpr int SHM_V = 64 * 128 * 2, SHM_K = 64 * 128 * 2;
#define KSWZ(row, colB) ((row) * 256 + ((colB) ^ (((row) & 7) << 4)))
#define SBAR() __builtin_amdgcn_sched_barrier(0)
__device__ __forceinline__ int crow(int r, int hi) { return (r & 3) + 8 * (r >> 2) + 4 * hi; }
__device__ __forceinline__ unsigned cvtpk(float lo, float hi) { unsigned r; asm volatile("v_cvt_pk_bf16_f32 %0, %1, %2" : "=v"(r) : "v"(lo), "v"(hi)); return r; }
__device__ __forceinline__ bf16x8 ld8(const bf16* p) { return *reinterpret_cast<const bf16x8*>(p); }

constexpr float THRL = 11.5f;
__device__ __forceinline__ void partialSM(f32x16& p0, f32x16& p1, float& mhat, f32x16& negm, float& alpha) {
  float pmax = p0[0];
#pragma unroll
  for (int r = 1; r < 16; ++r) pmax = fmaxf(pmax, p0[r]);
#pragma unroll
  for (int r = 0; r < 16; ++r) pmax = fmaxf(pmax, p1[r]);
  { auto rr = __builtin_amdgcn_permlane32_swap(__float_as_uint(pmax), __float_as_uint(pmax), false, false);
    pmax = fmaxf(__uint_as_float(rr[0]), __uint_as_float(rr[1])); }
  if (__builtin_expect(__all(pmax <= THRL), 1)) { alpha = 1.f; }
  else { const float dl = fmaxf(pmax, 0.f); mhat += dl; alpha = __builtin_amdgcn_exp2f(-dl);
#pragma unroll
    for (int r = 0; r < 16; ++r) { p0[r] -= dl; p1[r] -= dl; negm[r] = -mhat; } }
#pragma unroll
  for (int r = 0; r < 16; ++r) p0[r] = __builtin_amdgcn_exp2f(p0[r]);
}
__device__ __forceinline__ void finishSM(f32x16& p0, f32x16& p1, float alpha, float& l_reg, bf16x8& pa0, bf16x8& pa1, bf16x8& pa2, bf16x8& pa3) {
#pragma unroll
  for (int r = 0; r < 16; ++r) p1[r] = __builtin_amdgcn_exp2f(p1[r]);
  float ps = 0;
#pragma unroll
  for (int r = 0; r < 16; ++r) ps += p0[r];
#pragma unroll
  for (int r = 0; r < 16; ++r) ps += p1[r];
  { auto rr = __builtin_amdgcn_permlane32_swap(__float_as_uint(ps), __float_as_uint(ps), false, false);
    ps = __uint_as_float(rr[0]) + __uint_as_float(rr[1]); }
  l_reg = l_reg * alpha + ps;
#define PK4(P, BASE, OUT) do { unsigned a0 = cvtpk(P[BASE + 0], P[BASE + 1]), a1 = cvtpk(P[BASE + 2], P[BASE + 3]);   \
    unsigned b0 = cvtpk(P[BASE + 4], P[BASE + 5]), b1 = cvtpk(P[BASE + 6], P[BASE + 7]);                              \
    auto r0 = __builtin_amdgcn_permlane32_swap(a0, b0, false, false); auto r1 = __builtin_amdgcn_permlane32_swap(a1, b1, false, false); \
    u32x4 w = {r0[0], r1[0], r0[1], r1[1]}; OUT = *reinterpret_cast<bf16x8*>(&w); } while (0)
  PK4(p0, 0, pa0); PK4(p0, 8, pa1); PK4(p1, 0, pa2); PK4(p1, 8, pa3);
#undef PK4
}
template <int KP> __device__ __forceinline__ void qkt(f32x16& p0, f32x16& p1, const char* Ks, const bf16x8* qr, int r32, int hi, int kcb, const f32x16& negm) {
  p0 = negm; p1 = negm;
#pragma unroll
  for (int d0 = 0; d0 < 4; ++d0) { int cb = kcb + (d0 * 16 + hi * 8) * 2;
    bf16x8 b0 = *reinterpret_cast<const bf16x8*>(Ks + r32 * KP + (cb ^ ((r32 & 7) << 4)));
    bf16x8 b1 = *reinterpret_cast<const bf16x8*>(Ks + (32 + r32) * KP + (cb ^ ((r32 & 7) << 4)));
    p0 = __builtin_amdgcn_mfma_f32_32x32x16_bf16(b0, qr[d0], p0, 0, 0, 0);
    p1 = __builtin_amdgcn_mfma_f32_32x32x16_bf16(b1, qr[d0], p1, 0, 0, 0); }
}
__device__ __forceinline__ int v_st(int k, int c) { const int kk = (k & ~0xC) | ((k & 4) << 1) | ((k & 8) >> 1); return ((kk >> 3) * 4 + (c >> 5)) * 512 + ((kk & 7) * 32 + (c & 31)) * 2; }
__device__ __forceinline__ int v_rd_base(int lane) { return ((lane & 3) << 3) | (((lane >> 2) & 3) << 6) | (((lane >> 4) & 1) << 5) | (((lane >> 5) & 1) << 8); }
constexpr int v_rd_off(int d0, int ks, int half, bool w64 = false) { return w64 ? d0 * 512 + ks * 2048 + half * 1024 : d0 * 512 + ks * 4096 + half * 2048; }
template <int OFF> __device__ __forceinline__ s16x4 tr_read(int vb) {
  s16x4 r; asm volatile("ds_read_b64_tr_b16 %0, %1 offset:%2" : "=&v"(r) : "v"(vb), "i"(OFF) : "memory"); return r;
}
template <int D0, bool W64 = false> __device__ __forceinline__ void pv_one(f32x16& od, int vb, bf16x8 pa0, bf16x8 pa1, bf16x8 pa2, bf16x8 pa3) {
  const s16x4 l0 = tr_read<v_rd_off(D0, 0, 0, W64)>(vb), h0 = tr_read<v_rd_off(D0, 0, 1, W64)>(vb), l1 = tr_read<v_rd_off(D0, 1, 0, W64)>(vb), h1 = tr_read<v_rd_off(D0, 1, 1, W64)>(vb);
  const s16x4 l2 = tr_read<v_rd_off(D0, 2, 0, W64)>(vb), h2 = tr_read<v_rd_off(D0, 2, 1, W64)>(vb), l3 = tr_read<v_rd_off(D0, 3, 0, W64)>(vb), h3 = tr_read<v_rd_off(D0, 3, 1, W64)>(vb);
  asm volatile("s_waitcnt lgkmcnt(0)" ::: "memory"); SBAR();
#define PK(L, H) (bf16x8){L[0], L[1], L[2], L[3], H[0], H[1], H[2], H[3]}
  od = __builtin_amdgcn_mfma_f32_32x32x16_bf16(pa0, PK(l0, h0), od, 0, 0, 0);
  od = __builtin_amdgcn_mfma_f32_32x32x16_bf16(pa1, PK(l1, h1), od, 0, 0, 0);
  od = __builtin_amdgcn_mfma_f32_32x32x16_bf16(pa2, PK(l2, h2), od, 0, 0, 0);
  od = __builtin_amdgcn_mfma_f32_32x32x16_bf16(pa3, PK(l3, h3), od, 0, 0, 0);
#undef PK
}
template <int ND> __device__ __forceinline__ void pv_all(f32x16* o, int vb, bf16x8 pa0, bf16x8 pa1, bf16x8 pa2, bf16x8 pa3) {
  if constexpr (ND == 4) { pv_one<0>(o[0], vb, pa0, pa1, pa2, pa3); pv_one<1>(o[1], vb, pa0, pa1, pa2, pa3); pv_one<2>(o[2], vb, pa0, pa1, pa2, pa3); pv_one<3>(o[3], vb, pa0, pa1, pa2, pa3); }
  else { pv_one<0, true>(o[0], vb, pa0, pa1, pa2, pa3); pv_one<1, true>(o[1], vb, pa0, pa1, pa2, pa3); }
}
__device__ __forceinline__ void glds16(const void* gsrc, unsigned lds_dst) { unsigned keep;
  asm volatile("s_mov_b32 %0, m0\n\ts_mov_b32 m0, %2\n\ts_nop 0\n\tglobal_load_lds_dwordx4 %1, off\n\ts_mov_b32 m0, %0" : "=&s"(keep) : "v"(gsrc), "s"(lds_dst) : "memory"); }
struct TileSrc { const bf16* k; const bf16* v; int kpos0; };
template <int MODE> __device__ __forceinline__ TileSrc tile_src(const Frame& F, int path, int b, int hh, int qb, int j) {
  TileSrc t; t.kpos0 = -1;
  if (MODE == 0) {
    const size_t off = (path ? (size_t)(b * 4 + hh) * 2304 : (size_t)(b * 4 + hh) * 256) * 128 + (size_t)j * 64 * 128;
    t.k = (const bf16*)(F.ws + (path ? WS_KAL : WS_KAC)) + off; t.v = (const bf16*)(F.ws + (path ? WS_VAL : WS_VAC)) + off;
  } else {
    int kt = j;
    if (path) { const int nloc = 2 + (qb > 0 ? 2 : 0) + (qb < 15 ? 2 : 0);
      if (j < nloc) { if (j < 2) kt = 2 * qb + j; else if (qb > 0 && j < 4) kt = 2 * qb - 2 + (j - 2); else kt = 2 * qb + 2 + (j - (qb > 0 ? 4 : 2)); t.kpos0 = kt * 64; }
      else kt = 32 + (j - nloc); }
    const size_t off = (path ? (size_t)(b * 2 + hh) * 2304 : (size_t)(b * 2 + hh) * 256) * 64 + (size_t)kt * 64 * 64;
    t.k = (const bf16*)(F.ws + (path ? WS_KBL : WS_KBC)) + off; t.v = (const bf16*)(F.ws + (path ? WS_VBL : WS_VBC)) + off;
  }
  return t;
}
template <int MODE> struct Stg;
template <> struct Stg<0> { bf16x8 vs0, vs1, ks0, ks1; };
template <> struct Stg<1> { bf16x8 vs0, ks0; };

template <int MODE>
__device__ __forceinline__ void attn_unit(const Frame& F, int layer, int path, int b, int hh, int qb, char* lds) {
  constexpr int ND = MODE == 0 ? 4 : 2;
  int tid_ = threadIdx.x; asm volatile("" : "+v"(tid_));
  const int tid = tid_, wid = __builtin_amdgcn_readfirstlane(tid >> 6), lane = tid & 63, r32 = lane & 31, hi = lane >> 5;
  const int wq = wid & 3, wc = wid >> 2;
  constexpr int VB = MODE == 0 ? 16384 : 8192, SLOT = 2 * VB;
  constexpr int KP = MODE == 0 ? 256 : 128;
  constexpr int NP = MODE == 0 ? 2 : 1, NDMA = 2 * NP;
  float* ws = (float*)(lds + 131072 + 1024) + wid * 64; float* li_l = ws; float* al_l = ws + 32;
  const long rowbase = path ? NCTX + (long)b * 2048 : (long)b * 256;
  const long qrow0 = rowbase + qb * 128 + wq * 32;
  const int qcol = MODE == 0 ? C_QA + hh * 128 + wc * 64 : C_QB + (hh * 2 + wc) * 64;
  const int kcb = MODE == 0 ? wc * 128 : 0;
  const int NT = MODE == 0 ? (path ? 36 : 4) : (path ? 6 + (qb > 0 ? 2 : 0) + (qb < 15 ? 2 : 0) : 4);
  const int qpos = qb * 128 + wq * 32 + r32;
  float mhat = 0.f, l_reg = 0; f32x16 o[ND]; bf16x8 qr[4]; f32x16 negm = f32x16{};
#pragma unroll
  for (int d = 0; d < ND; ++d) o[d] = f32x16{};
  const unsigned lds0 = (unsigned)(uintptr_t)lds;
  const int vb0 = (int)lds0 + v_rd_base(lane);
  int ksrc[NP], vsrc[NP];
#pragma unroll
  for (int i = 0; i < NP; ++i) { const int o_ = (wid * NP + i) * 1024 + lane * 16;
    if (MODE == 0) { const int r = o_ >> 8, c_ = (o_ >> 4) & 15; ksrc[i] = r * 256 + ((c_ ^ (r & 7)) << 4);
      const int st = o_ >> 9, w_ = o_ & 511, kk = (st >> 2) * 8 + (w_ >> 6), k = (kk & ~0xC) | ((kk & 4) << 1) | ((kk & 8) >> 1), c = (st & 3) * 32 + ((w_ & 63) >> 1); vsrc[i] = k * 256 + c * 2; }
    else { const int r = o_ >> 7, c_ = (o_ >> 4) & 7; ksrc[i] = r * 128 + ((c_ ^ (r & 7)) << 4);
      const int st = o_ >> 9, w_ = o_ & 511, kk = (st >> 1) * 8 + (w_ >> 6), k = (kk & ~0xC) | ((kk & 4) << 1) | ((kk & 8) >> 1), c = (st & 1) * 32 + ((w_ & 63) >> 1); vsrc[i] = k * 128 + c * 2; } }
#define DMA_TILE(j_, so) do { const TileSrc ts_ = tile_src<MODE>(F, path, b, hh, qb, (j_)); \
    _Pragma("unroll") for (int i = 0; i < NP; ++i) { const unsigned d_ = lds0 + (unsigned)(so) + (unsigned)((wid * NP + i) * 1024); \
      glds16((const char*)ts_.v + vsrc[i], (unsigned)__builtin_amdgcn_readfirstlane(d_)); glds16((const char*)ts_.k + ksrc[i], (unsigned)__builtin_amdgcn_readfirstlane(d_ + VB)); } } while (0)
#define DMA_WAIT(n) do { if ((n) == 0) asm volatile("s_waitcnt vmcnt(0)" ::: "memory"); else if (NDMA == 4) asm volatile("s_waitcnt vmcnt(4)" ::: "memory"); else asm volatile("s_waitcnt vmcnt(2)" ::: "memory"); } while (0)
#define RESC(a) do { if (__any((a) < 1.f)) { if (hi == 0) al_l[r32] = (a); asm volatile("s_waitcnt lgkmcnt(0)" ::: "memory"); \
    _Pragma("unroll") for (int d = 0; d < ND; ++d) _Pragma("unroll") for (int r = 0; r < 16; ++r) o[d][r] *= al_l[crow(r, hi)]; } } while (0)
#define MASK(P0, P1, j_) do { if (MODE == 1 && path == 1 && (j_) >= 2) { const TileSrc tm_ = tile_src<MODE>(F, path, b, hh, qb, (j_)); if (tm_.kpos0 >= 0) { \
    const unsigned db_ = (unsigned)(tm_.kpos0 - qpos + 4 * hi + 128);     \
    _Pragma("unroll") for (int r = 0; r < 16; ++r) { const unsigned c_ = (unsigned)((r & 3) + 8 * (r >> 2)); \
      if (db_ + c_ > 256u) P0[r] = -__builtin_inff(); if (db_ + c_ + 32u > 256u) P1[r] = -__builtin_inff(); } } } } while (0)
  f32x16 pA0, pA1, pB0, pB1; float alA, alB; bf16x8 pa0, pa1, pa2, pa3;
  int s_prev = 0, s_cur = SLOT, s_dma = 3 * SLOT;
#define ROT() do { s_prev = s_cur; s_cur = (s_cur + SLOT) & (4 * SLOT - 1); s_dma = (s_dma + SLOT) & (4 * SLOT - 1); } while (0)
#define STEP(PC0, PC1, ALC, PP0, PP1, ALP, j_) do { const bool more_ = (j_) + 2 < NT; if (more_) DMA_TILE((j_) + 2, s_dma); \
    SBAR(); qkt<KP>(PC0, PC1, lds + s_cur + VB, qr, r32, hi, kcb, negm); \
    finishSM(PP0, PP1, ALP, l_reg, pa0, pa1, pa2, pa3); SBAR(); \
    pv_all<ND>(o, vb0 + s_prev, pa0, pa1, pa2, pa3); MASK(PC0, PC1, (j_)); partialSM(PC0, PC1, mhat, negm, ALC); \
    RESC(ALC); if (more_) DMA_WAIT(1); else DMA_WAIT(0); __syncthreads(); ROT(); } while (0)
  DMA_TILE(0, 0); DMA_TILE(1, SLOT); DMA_TILE(2, 2 * SLOT);
  { const bf16* Qw = F.PROJ() + (qrow0 + r32) * LDP + qcol + hi * 8;
#pragma unroll
    for (int d0 = 0; d0 < 4; ++d0) qr[d0] = ld8(Qw + d0 * 16); }
  DMA_WAIT(1); __syncthreads();
  qkt<KP>(pA0, pA1, lds + VB, qr, r32, hi, kcb, negm); MASK(pA0, pA1, 0); partialSM(pA0, pA1, mhat, negm, alA);
  for (int j = 1; j + 1 < NT; j += 2) {
    STEP(pB0, pB1, alB, pA0, pA1, alA, j);
    STEP(pA0, pA1, alA, pB0, pB1, alB, j + 1);
  }
  SBAR(); qkt<KP>(pB0, pB1, lds + s_cur + VB, qr, r32, hi, kcb, negm);
  finishSM(pA0, pA1, alA, l_reg, pa0, pa1, pa2, pa3); SBAR();
  pv_all<ND>(o, vb0 + s_prev, pa0, pa1, pa2, pa3); MASK(pB0, pB1, NT - 1); partialSM(pB0, pB1, mhat, negm, alB);
  RESC(alB);
  finishSM(pB0, pB1, alB, l_reg, pa0, pa1, pa2, pa3); SBAR();
  pv_all<ND>(o, vb0 + s_cur, pa0, pa1, pa2, pa3);
#undef STEP
#undef ROT
#undef DMA_TILE
#undef DMA_WAIT
#undef RESC
#undef MASK
  if (MODE == 1) { const float sk = in_ptr(17)[layer * 4 + hh * 2 + wc]; l_reg += __builtin_amdgcn_exp2f(sk * 1.4426950408889634f - mhat); }
  if (hi == 0) li_l[r32] = l_reg; asm volatile("s_waitcnt lgkmcnt(0)" ::: "memory");
  float rli[16];
#pragma unroll
  for (int r = 0; r < 16; ++r) rli[r] = __builtin_amdgcn_rcpf(li_l[crow(r, hi)]);
  if (MODE == 0) {
    const float lam = F.ROPE()[2048 + layer * 2], omli = F.ROPE()[2048 + layer * 2 + 1];
    float* X = (float*)lds;
    __syncthreads();
    if (wc == 1) {
#pragma unroll
      for (int d = 0; d < 4; ++d)
#pragma unroll
        for (int r = 0; r < 16; ++r) X[((wq * 4 + d) * 16 + r) * 64 + lane] = o[d][r] * rli[r] * lam;
    }
    __syncthreads();
    if (wc == 0) {
      const float* dg = in_ptr(16) + layer * 128;
      float dgv[4];
#pragma unroll
      for (int d = 0; d < 4; ++d) dgv[d] = dg[32 * d + r32] * omli;
      unsigned short zv[16][4];
#pragma unroll
      for (int r = 0; r < 16; ++r) { const bf16* zr = F.PROJ() + (qrow0 + crow(r, hi)) * LDP + C_Z + hh * 128 + r32;
#pragma unroll
        for (int d = 0; d < 4; ++d) zv[r][d] = zr[32 * d]; }
#pragma unroll
      for (int r = 0; r < 16; ++r) {
        float v[4]; float ss = 0.f;
#pragma unroll
        for (int d = 0; d < 4; ++d) { v[d] = o[d][r] * rli[r] - X[((wq * 4 + d) * 16 + r) * 64 + lane]; ss += v[d] * v[d]; }
#pragma unroll
        for (int off = 1; off < 32; off <<= 1) ss += __shfl_xor(ss, off);
        const float rstd = 1.f / sqrtf(ss * (1.f / 128.f) + RMS_EPS);
        bf16* mr = F.PROJ() + (qrow0 + crow(r, hi)) * LDP + C_Z + hh * 128 + r32;
#pragma unroll
        for (int d = 0; d < 4; ++d) mr[32 * d] = (bf16)f2bf(v[d] * rstd * dgv[d] * bf2f(zv[r][d]));
      }
    }
    __syncthreads();
  } else {
    const int mc = 512 + (hh * 2 + wc) * 64 + r32;
    unsigned short zv[16][2];
#pragma unroll
    for (int r = 0; r < 16; ++r) { const bf16* zr = F.PROJ() + (qrow0 + crow(r, hi)) * LDP + C_Z + mc; zv[r][0] = zr[0]; zv[r][1] = zr[32]; }
#pragma unroll
    for (int r = 0; r < 16; ++r) {
      bf16* mr = F.PROJ() + (qrow0 + crow(r, hi)) * LDP + C_Z + mc;
#pragma unroll
      for (int d = 0; d < 2; ++d) mr[32 * d] = (bf16)f2bf(o[d][r] * rli[r] * bf2f(zv[r][d]));
    }
    __syncthreads();
  }
}

__device__ __forceinline__ void fourier_unit(const Frame& F, int path, int b, int kb, int cb, char* lds) {
  int tid_ = threadIdx.x; asm volatile("" : "+v"(tid_));
  const int tid = tid_, wid = __builtin_amdgcn_readfirstlane(tid >> 6), lane = tid & 63, r32 = lane & 31, hi = lane >> 5;
  char* V_lds = lds;
  const int S = path ? 2048 : 256, TPP = S / 64, NT = 2 * TPP;
  const long rowbase = path ? NCTX + (long)b * 2048 : (long)b * 256;
  const int k0 = kb * 256 + wid * 32;
  const bf16* Dm = F.DFTC() + (long)(k0 + r32) * (2 * S) + hi * 8;
  const int sr = tid >> 3, sc = (tid & 7) * 8;
  const int vst0 = v_st(sr, sc);
  const int vb0 = (int)(uintptr_t)V_lds + v_rd_base(lane);
  f32x16 o[2]; o[0] = f32x16{}; o[1] = f32x16{};
  bf16x8 a0, a1, a2, a3, n0, n1, n2, n3; n0 = n1 = n2 = n3 = bf16x8{};
#define FV_SRC(j_) (F.PROJ() + (rowbase + ((j_) % TPP) * 64 + sr) * LDP + C_VF + ((j_) / TPP) * 256 + cb * 64 + sc)
#define FA_LOAD(A0, A1, A2, A3, j_) do { const bf16* p_ = Dm + ((j_) / TPP) * S + ((j_) % TPP) * 64; A0 = ld8(p_); A1 = ld8(p_ + 16); A2 = ld8(p_ + 32); A3 = ld8(p_ + 48); } while (0)
  { bf16x8 vr[8];
#pragma unroll
    for (int j = 0; j < 8; ++j) vr[j] = ld8(FV_SRC(j));
    FA_LOAD(a0, a1, a2, a3, 0);
#pragma unroll
    for (int j = 0; j < 8; ++j) *(bf16x8*)(V_lds + j * SHM_V + vst0) = vr[j]; }
  __syncthreads();
#pragma unroll 2
  for (int j = 0; j < NT; ++j) {
    if (j + 1 < NT) FA_LOAD(n0, n1, n2, n3, j + 1);
    pv_one<0>(o[0], vb0 + j * SHM_V, a0, a1, a2, a3); pv_one<1>(o[1], vb0 + j * SHM_V, a0, a1, a2, a3);
    a0 = n0; a1 = n1; a2 = n2; a3 = n3;
  }
  __syncthreads();
#undef FV_SRC
#undef FA_LOAD
  { const int mc = 768 + cb * 64 + r32;
    unsigned short zv[16][2];
#pragma unroll
    for (int r = 0; r < 16; ++r) { const bf16* zr = F.PROJ() + (rowbase + k0 + crow(r, hi)) * LDP + C_Z + mc; zv[r][0] = zr[0]; zv[r][1] = zr[32]; }
#pragma unroll
    for (int r = 0; r < 16; ++r) { bf16* mr = F.PROJ() + (rowbase + k0 + crow(r, hi)) * LDP + C_Z + mc;
#pragma unroll
      for (int d = 0; d < 2; ++d) mr[32 * d] = (bf16)f2bf(o[d][r] * bf2f(zv[r][d])); } }
}

__device__ __forceinline__ void fft_unit(const Frame& F, int b, int cs, char* lds) {
  int tid_ = threadIdx.x; asm volatile("" : "+v"(tid_));
  const int tid = tid_, w = __builtin_amdgcn_readfirstlane(tid >> 6), lane = tid & 63, r32 = lane & 31, hi = lane >> 5;
  const long rowbase = NCTX + (long)b * 2048; const int col0 = cs * 8;
  const bf16* P = F.PROJ();
  bf16x8 a1[2][4], a2[2][8], zg[4];
  { bf16x8 v[8];
#pragma unroll
    for (int it = 0; it < 8; ++it) v[it] = ld8((const bf16*)(F.ws + WS_VFT) + ((size_t)(b * 32 + cs) * 4096 + it * 512 + tid) * 8);
    { const bf16* M1p = F.FM1() + r32 * 64 + hi * 8;
#pragma unroll
      for (int rh = 0; rh < 2; ++rh)
#pragma unroll
        for (int ks = 0; ks < 4; ++ks) a1[rh][ks] = ld8(M1p + rh * 32 * 64 + ks * 16); }
#pragma unroll
    for (int it = 0; it < 8; ++it) { const int q = it * 512 + tid, ri = q >> 11, s = q & 2047, s1 = s >> 6, s2 = s & 63;
      *(bf16x8*)(lds + (s2 >> 4) * 16384 + v_st(ri * 32 + s1, (s2 & 15) * 8)) = v[it]; } }
  __syncthreads();
#pragma unroll
  for (int it = 0; it < 4; ++it) zg[it] = ld8(P + (rowbase + it * 512 + tid) * LDP + C_Z + 768 + col0);
  { const bf16* M2p = F.FM2() + r32 * 128 + hi * 8;
#pragma unroll
    for (int rh = 0; rh < 2; ++rh)
#pragma unroll
      for (int ks = 0; ks < 8; ++ks) a2[rh][ks] = ld8(M2p + rh * 32 * 128 + ks * 16); }
  f32x16 o1[2][2];
  { const int vb = (int)(uintptr_t)lds + (w >> 1) * 16384 + (w & 1) * 1024 + v_rd_base(lane);
#pragma unroll
    for (int rh = 0; rh < 2; ++rh) { o1[rh][0] = f32x16{}; o1[rh][1] = f32x16{}; }
#pragma unroll
    for (int rh = 0; rh < 2; ++rh) { pv_one<0>(o1[rh][0], vb, a1[rh][0], a1[rh][1], a1[rh][2], a1[rh][3]); pv_one<1>(o1[rh][1], vb, a1[rh][0], a1[rh][1], a1[rh][2], a1[rh][3]); } }
  char* XB = lds + 65536;
  {
#pragma unroll
    for (int d = 0; d < 2; ++d) { const int s2 = 8 * w + d * 4 + (r32 >> 3), col = r32 & 7; const float s2f = (float)s2 * (1.f / 2048.f);
#pragma unroll
      for (int rq = 0; rq < 4; ++rq) { float yr[4], yi[4];
#pragma unroll
        for (int e = 0; e < 4; ++e) { const int r = 4 * rq + e, k1 = 8 * rq + 4 * hi + e; const float rev = (float)k1 * s2f;
          const float tc = __builtin_amdgcn_cosf(rev), tsn = __builtin_amdgcn_sinf(rev);
          const float xr = o1[0][d][r], xi = o1[1][d][r]; yr[e] = xr * tc + xi * tsn; yi[e] = xi * tc - xr * tsn; }
        const int off = (col >> 2) * 16384 + v_st(s2, (col & 3) * 32 + 8 * rq + 4 * hi);
        uint2 pr, pi; pr.x = cvtpk(yr[0], yr[1]); pr.y = cvtpk(yr[2], yr[3]); pi.x = cvtpk(yi[0], yi[1]); pi.y = cvtpk(yi[2], yi[3]);
        *(uint2*)(XB + off) = pr; *(uint2*)(XB + 2 * 16384 + off) = pi; } } }
  __syncthreads();
  f32x16 o2[2];
  { const int vre = (int)(uintptr_t)XB + (w >> 2) * 16384 + (w & 3) * 512 + v_rd_base(lane), vim = vre + 2 * 16384;
#pragma unroll
    for (int rh = 0; rh < 2; ++rh) { o2[rh] = f32x16{};
      pv_one<0>(o2[rh], vre, a2[rh][0], a2[rh][1], a2[rh][2], a2[rh][3]); pv_one<0>(o2[rh], vim, a2[rh][4], a2[rh][5], a2[rh][6], a2[rh][7]); } }
  float* OUTS = (float*)lds;
#pragma unroll
  for (int rh = 0; rh < 2; ++rh)
#pragma unroll
    for (int r = 0; r < 16; ++r) { const int k = r32 + 32 * (crow(r, hi) + 32 * rh); OUTS[k * 8 + w] = o2[rh][r] * 0.02209708691207961f; }
  __syncthreads();
#pragma unroll
  for (int it = 0; it < 4; ++it) { const int k = it * 512 + tid; const long row = rowbase + k;
    const bf16x8 z = zg[it];
    const f32x4 x0 = *(const f32x4*)(OUTS + k * 8), x1 = *(const f32x4*)(OUTS + k * 8 + 4);
    u32x4 o; o.x = cvtpk(x0.x * bf2f((unsigned short)z[0]), x0.y * bf2f((unsigned short)z[1])); o.y = cvtpk(x0.z * bf2f((unsigned short)z[2]), x0.w * bf2f((unsigned short)z[3]));
    o.z = cvtpk(x1.x * bf2f((unsigned short)z[4]), x1.y * bf2f((unsigned short)z[5])); o.w = cvtpk(x1.z * bf2f((unsigned short)z[6]), x1.w * bf2f((unsigned short)z[7]));
    *(u32x4*)(F.PROJ() + row * LDP + C_Z + 768 + col0) = o; }
  __syncthreads();
}
#undef KSWZ
#undef SBAR
}

__device__ __forceinline__ void phase_prologue(Frame& F) {
    const int G = F.G, bid = blockIdx.x, tid = F.tid;
    {
        LAS float* sc = (LAS float*)(F.lds + RING_OFF);
        LAS float* red = (LAS float*)(F.lds + RING_OFF + 12 * 1024 * 4);
        bool have = false;
        for (int job = bid; job < 192; job += G) {
            if (!have) { for (int i = tid; i < 9 * 1024; i += 512) { const int p = i >> 10, k = i & 1023; const float v = p == 0 ? in_ptr(7)[k] : in_ptr(6)[(p - 1) * 1024 + k]; sc[k * 12 + p] = silu_f(v); } have = true; }
            __syncthreads();
            const int l = job / 48, j0 = (job % 48) * 64, ks = tid >> 6, jj = tid & 63;
            float acc[9];
#pragma unroll
            for (int p = 0; p < 9; ++p) acc[p] = 0.f;
            const float* wp = in_ptr(8) + ((size_t)l * 1024 + ks * 128) * 3072 + j0 + jj;
            for (int k0 = 0; k0 < 128; k0 += 32) { float wl[32];
#pragma unroll
                for (int kk = 0; kk < 32; ++kk) wl[kk] = wp[(size_t)(k0 + kk) * 3072];
#pragma unroll
                for (int kk = 0; kk < 32; ++kk) { const LAS f32x4* sp = (const LAS f32x4*)(sc + (ks * 128 + k0 + kk) * 12); const f32x4 s0 = sp[0], s1 = sp[1], s2 = sp[2]; const float w = wl[kk];
                    acc[0] += s0.x * w; acc[1] += s0.y * w; acc[2] += s0.z * w; acc[3] += s0.w * w; acc[4] += s1.x * w; acc[5] += s1.y * w; acc[6] += s1.z * w; acc[7] += s1.w * w; acc[8] += s2.x * w; } }
#pragma unroll
            for (int p = 0; p < 9; ++p) red[(ks * 64 + jj) * 9 + p] = acc[p];
            __syncthreads();
            for (int i = tid; i < 64 * 9; i += 512) { const int j2 = i / 9, p = i % 9; float s = 0.f;
#pragma unroll
                for (int q = 0; q < 8; ++q) s += red[(q * 64 + j2) * 9 + p];
                F.MOD()[((size_t)l * 9 + p) * 3072 + j0 + j2] = s + in_ptr(9)[l * 3072 + j0 + j2]; }
        }
        __syncthreads();
    }
    const long gt = (long)bid * 512 + tid, NGT = (long)G * 512;
    for (long i = gt; i < 4 * 4 * 64 * 128; i += NGT) {
        const int n2 = (int)(i & 127), c = (int)((i >> 7) & 63), lg = (int)(i >> 13); const int ri = n2 >> 6, d = n2 & 63;
        const float* wf = in_ptr(18) + (size_t)lg * 4096 + d; float s = 0.f;
#pragma unroll 16
        for (int j = 0; j < 64; ++j) { const float rev = (float)((j * c) & 63) * (1.f / 64.f); const float t = ri ? -__builtin_amdgcn_sinf(rev) : __builtin_amdgcn_cosf(rev); s += t * wf[j * 64]; }
        F.GF()[i] = s * 0.125f;
    }
    const long goff = G > 194 ? 192L * 512 : 0, gi = gt - goff;
    if (gi >= 0) for (long i = gi; i < 1024; i += NGT - goff) { const int pos = (int)(i >> 4), fi = (int)(i & 15); const float inv = powf(10000.f, -(float)fi / 16.f); const float ang = (float)pos * inv; F.ROPE()[i] = cosf(ang); F.ROPE()[1024 + i] = sinf(ang); }
    if (gi >= 1024 && gi < 1028) { const int l = (int)(gi - 1024); float s1 = 0.f, s2 = 0.f;
        for (int k = 0; k < 64; ++k) { s1 += in_ptr(12)[l * 64 + k] * in_ptr(13)[l * 64 + k]; s2 += in_ptr(14)[l * 64 + k] * in_ptr(15)[l * 64 + k]; }
        const float li = 0.8f - 0.6f * expf(-0.3f * (float)l);
        F.ROPE()[2048 + 2 * l] = expf(s1) - expf(s2) + li; F.ROPE()[2048 + 2 * l + 1] = 1.f - li; }
    for (long i = gt; i < 64 * 64; i += NGT) { const int rr = (int)(i >> 6), cc = (int)(i & 63); const int rip = rr >> 5, k1 = rr & 31, ri = cc >> 5, s1 = cc & 31;
        const float rev = (float)((k1 * s1) & 31) * (1.f / 32.f); const float cs = __builtin_amdgcn_cosf(rev), sn = __builtin_amdgcn_sinf(rev);
        F.FM1()[i] = (bf16)f2bf(rip == ri ? cs : (rip == 0 ? sn : -sn)); }
    for (long i = gt; i < 64 * 128; i += NGT) { const int k2 = (int)(i >> 7), cc = (int)(i & 127); const int s2 = cc & 63;
        const float rev = (float)((k2 * s2) & 63) * (1.f / 64.f); F.FM2()[i] = (bf16)f2bf(cc < 64 ? __builtin_amdgcn_cosf(rev) : __builtin_amdgcn_sinf(rev)); }
    for (long i = gt; i < 256L * 512 / 8; i += NGT) { const int k = (int)(i >> 6), c0 = (int)(i & 63) * 8; const int part = c0 >> 8; v4u o; unsigned short h[8];
#pragma unroll
        for (int e = 0; e < 8; ++e) { const int s = (c0 + e) & 255; const float rev = (float)((k * s) & 255) * (1.f / 256.f); const float t = part ? __builtin_amdgcn_sinf(rev) : __builtin_amdgcn_cosf(rev); h[e] = (unsigned short)f2bf(t * 0.0625f); }
        o.x = h[0] | ((unsigned)h[1] << 16); o.y = h[2] | ((unsigned)h[3] << 16); o.z = h[4] | ((unsigned)h[5] << 16); o.w = h[6] | ((unsigned)h[7] << 16);
        *(GAS v4u*)(F.DFTC() + i * 8) = o; }
}
__device__ __forceinline__ void weight_prep(Frame& F, int l, int gw, int NGW, int gt, int NGT, int pwave, int plane, int which = 7) {
    if (which & 5) {
        LAS float* scr = (LAS float*)(F.lds + RING_OFF + pwave * 16384);
        constexpr int I_IN = 16 * 104, I_OUT = 16 * 32, I_FOLD = 1024, NITEMS = I_FOLD + I_IN + I_OUT;
        const float* win_l = in_ptr(11) + (size_t)l * DM * NIN; const float* wout_l = in_ptr(19) + (size_t)l * DM * DM;
        for (int it = gw; it < NITEMS; it += NGW) {
            int r = it;
            if (r < I_FOLD) { if (which & 4) fold_item(win_l, F.GF() + (size_t)l * 4 * 64 * 128, F.WIN(l), scr, r, plane); continue; } r -= I_FOLD;
            if (!(which & 1)) break;
            if (r < I_IN) { const int nb = r % 104; if (nb >= 64 && nb < 72) continue; p0_transpose_item(win_l, DM, NIN, F.WIN(l), nb >= 72 ? 256 : 0, scr, r, plane); continue; } r -= I_IN;
            p0_transpose_item(wout_l, DM, DM, F.WOUT(l), 0, scr, r, plane);
        }
    }
    if (which & 2) {
        constexpr int NA = 8 * 256 * 512 / 8, NB = 8 * 256 * 128 / 8;
        for (int ib = gt; ib < 2 * NA + 2 * NB; ib += 3 * NGT) {
            f32x4 a[3], c[3]; bf16* dst[3];
#pragma unroll
            for (int u = 0; u < 3; ++u) { const int i = ib + u * NGT; dst[u] = nullptr;
                if (i < 2 * NA + 2 * NB) { const float* src;
                    if (i < 2 * NA) { const bool isv = i >= NA; const int e = (isv ? i - NA : i) * 8; const int b = (int)(e >> 17), t = (int)(e >> 9) & 255, h = (int)(e >> 7) & 3, c8 = (int)e & 127;
                        src = in_ptr(isv ? 3 : 2) + ((long)(b * 4 + l) << 17) + (e & 131071); dst[u] = (bf16*)(F.ws + (isv ? WS_VAL : WS_KAL)) + ((size_t)(b * 4 + h) * 2304 + 2048 + t) * 128 + c8; }
                    else { const int i2 = i - 2 * NA; const bool isv = i2 >= NB; const int e = (isv ? i2 - NB : i2) * 8; const int b = (int)(e >> 15), t = (int)(e >> 7) & 255, kvh = (int)(e >> 6) & 1, c8 = (int)e & 63;
                        src = in_ptr(isv ? 5 : 4) + ((long)(b * 4 + l) << 15) + (e & 32767); dst[u] = (bf16*)(F.ws + (isv ? WS_VBL : WS_KBL)) + ((size_t)(b * 2 + kvh) * 2304 + 2048 + t) * 64 + c8; }
                    a[u] = *(const f32x4*)src; c[u] = *(const f32x4*)(src + 4); } }
#pragma unroll
            for (int u = 0; u < 3; ++u) if (dst[u]) { v4u o; o.x = pk2(a[u].x, a[u].y); o.y = pk2(a[u].z, a[u].w); o.z = pk2(c[u].x, c[u].y); o.w = pk2(c[u].z, c[u].w);
                *(GAS v4u*)dst[u] = o; }
        }
    }
}
__device__ __forceinline__ void stream_rows(Frame& F, int l, int r0, int w0, int wn) {
    int tid_ = threadIdx.x; asm volatile("" : "+v"(tid_));
    const int plane = tid_ & 63, pwave = __builtin_amdgcn_readfirstlane(tid_ >> 6);
    float* X = F.out;
    const float* ng = l == DEPTH ? in_ptr(20) : in_ptr(10) + l * DM;
    f32x4 av[4], sv[4]; int pc = -1;
#pragma unroll
    for (int j = 0; j < 4; ++j) { av[j] = f32x4{0.f, 0.f, 0.f, 0.f}; sv[j] = av[j]; }
    for (int i = pwave; i < wn; i += 2 * NWAVES) {
        const float* xprev[2]; const bf16* drow[2]; float* xw[2]; bf16* hn[2]; float* yrow[2]; const float* modp[2]; int pr[2];
#pragma unroll
        for (int r = 0; r < 2; ++r) {
            const int ii = i + r * NWAVES; const bool on = ii < wn; const int m = r0 + w0 + (on ? ii : i);
            const bool ctx = m < NCTX; const int p = ctx ? 0 : 1 + ((m - NCTX) >> 11);
            const float* xin = ctx ? in_ptr(0) + (size_t)m * DM : in_ptr(1) + (size_t)(m - NCTX) * DM;
            xprev[r] = on ? (l <= 1 ? xin : X + (size_t)m * DM) : nullptr;
            drow[r] = l == 0 ? nullptr : F.ACT() + (size_t)m * DM;
            xw[r] = (l == 0 || l == DEPTH) ? nullptr : X + (size_t)m * DM;
            hn[r] = F.ACT() + (size_t)m * DM; yrow[r] = X + (size_t)m * DM;
            modp[r] = F.MOD() + ((size_t)(l == DEPTH ? 0 : l) * 9 + p) * 3072; pr[r] = p;
        }
        if (l == DEPTH) stream_row<true, 2>(xprev, drow, xw, hn, yrow, ng, modp, pr, pc, av, sv, plane, true);
        else stream_row<false, 2>(xprev, drow, xw, hn, yrow, ng, modp, pr, pc, av, sv, plane, l >= 2);
    }
}
__device__ __forceinline__ void even_share(int n, int G_, int c, int& w0, int& wn) { int G = G_; asm volatile("" : "+s"(G));
    const int q = n / G, r = n % G; w0 = c * q + (c < r ? c : r); wn = q + (c < r ? 1 : 0); }
__device__ __forceinline__ void mix_list(Frame& F, int l, bool lat, char* lds) {
    int bid_ = blockIdx.x; asm volatile("" : "+s"(bid_));
    const int np = lat ? 1280 : 768;
    for (int p = bid_; p < np; p += F.G) {
        int type = -1, path = lat ? 1 : 0, b = 0, hh = 0, qb = 0;
        if (lat) {
            if (p < 512) { const int seg = p >> 8, within = p & 255, x = within & 7, li = within >> 3, idx = seg * 32 + li, j = idx >> 4, bh = x + 8 * j; type = 0; qb = idx & 15; b = bh >> 2; hh = bh & 3; }
            else if (p < 768) { const int u = p - 512, x = u & 7, li = u >> 3; type = 1; b = x; hh = li >> 4; qb = li & 15; }
            else if (p >= 896 && p < 1024) { const int u = p - 896; type = 3; b = u >> 5; hh = u & 31; }
            else if (p >= 1152) { const int u = p - 1152 + 128; type = 3; b = u >> 5; hh = u & 31; }
        } else {
            if (p < 256) { type = 0; b = p >> 3; hh = (p >> 1) & 3; qb = p & 1; }
            else if (p >= 384 && p < 512) { const int u = p - 384; type = 1; b = u >> 2; hh = (u >> 1) & 1; qb = u & 1; }
            else if (p >= 640) { const int u = p - 640; type = 2; b = u >> 2; hh = u & 3; }
        }
        if (type == 0) att::attn_unit<0>(F, l, path, b, hh, qb, lds);
        if (type == 1) att::attn_unit<1>(F, l, path, b, hh, qb, lds);
        if (type == 2) att::fourier_unit(F, 0, b, 0, hh, lds);
        if (type == 3) att::fft_unit(F, b, hh, lds);
    }
}
constexpr int CW_CHL = 8192, CW_CHC = 12288; static_assert((size_t)(CW_CHC + XCD_BAR_WORDS) * 4 <= CTL_ZERO_BYTES && CW_BAR + XCD_BAR_WORDS <= CW_CHL, "control words inside the per-call memset");
__device__ __forceinline__ void chain_arrive(Frame& F, int cw) {
    asm volatile("s_waitcnt vmcnt(0)" ::: "memory");
    __syncthreads();
    if (threadIdx.x == 0) {
        unsigned* bar = (unsigned*)F.ws + cw; volatile LAS unsigned* st = (volatile LAS unsigned*)(F.lds + MISC_OFF) + 8;
        __builtin_amdgcn_s_waitcnt(0);
        const unsigned nloc = st[0], x = xb_xcc_id();
        const unsigned old = xb_add(&bar[XB_XSUB(x)], 1u);
        if ((old + 1u) % nloc == 0u) { __builtin_amdgcn_fence(__ATOMIC_RELEASE, "agent"); asm volatile("s_waitcnt vmcnt(0)" ::: "memory"); xb_add(&bar[XB_TOP], 1u); }
    }
}
__device__ __forceinline__ void chain_step(Frame& F, int cwa, int cww, unsigned gen) {
    asm volatile("s_waitcnt vmcnt(0)" ::: "memory");
    __syncthreads();
    if (threadIdx.x == 0) {
        unsigned* bara = (unsigned*)F.ws + cwa; unsigned* barw = (unsigned*)F.ws + cww; volatile LAS unsigned* st = (volatile LAS unsigned*)(F.lds + MISC_OFF) + 8;
        __builtin_amdgcn_s_waitcnt(0);
        const unsigned nloc = st[0], need = st[1] * gen, x = xb_xcc_id();
        const unsigned old = xb_add(&bara[XB_XSUB(x)], 1u);
        unsigned top = xb_ld(&barw[XB_TOP]);
        if ((old + 1u) % nloc == 0u) { __builtin_amdgcn_fence(__ATOMIC_RELEASE, "agent"); asm volatile("s_waitcnt vmcnt(0)" ::: "memory"); (void)xb_add(&bara[XB_TOP], 1u); }
        if (top < need) XB_SPIN(xb_ld(&barw[XB_TOP]) < need, barw);
        if (gen) { __builtin_amdgcn_fence(__ATOMIC_ACQUIRE, "agent"); asm volatile("s_waitcnt vmcnt(0)" ::: "memory"); }
    }
    __syncthreads();
}
__device__ __forceinline__ void chain_wait(Frame& F, int cw, unsigned gen) {
    if (threadIdx.x == 0) {
        unsigned* bar = (unsigned*)F.ws + cw; volatile LAS unsigned* st = (volatile LAS unsigned*)(F.lds + MISC_OFF) + 8;
        const unsigned need = st[1] * gen;
        XB_SPIN(xb_ld(&bar[XB_TOP]) < need, bar);
        __builtin_amdgcn_fence(__ATOMIC_ACQUIRE, "agent"); asm volatile("s_waitcnt vmcnt(0)" ::: "memory");
    }
    __syncthreads();
}
struct Args { const float* in[21]; float* out; unsigned char* ws; };
__global__ void __launch_bounds__(NWAVES * 64, 2) mk_fwd(Args args) {
    extern __shared__ __attribute__((aligned(16))) unsigned char lds[];
    Frame F;
    F.lds = (LAS unsigned char*)lds;
    F.tid = threadIdx.x; F.lane = F.tid & 63; F.wave = __builtin_amdgcn_readfirstlane(F.tid >> 6);
    F.G = gridDim.x;
    unsigned char* ws = args.ws;
    F.out = args.out; F.ws = ws;
    for (int u = F.tid; u < (LDS_BYTES - LDSCTL_OFF) / 4; u += NWAVES * 64) ((LAS unsigned*)(F.lds + LDSCTL_OFF))[u] = 0u;
    __syncthreads();
    (void)xcd_barrier_post((unsigned*)ws + CW_BAR, (volatile LAS unsigned*)(F.lds + MISC_OFF) + 8);
#ifdef PROBE_BAR2
#define GRID_BAR() do { GRID_BAR1(); GRID_BAR1(); } while (0)
#else
#define GRID_BAR() GRID_BAR1()
#endif
#define GRID_BAR1() do { XcdBarrier bar_; bar_.bar = (unsigned*)F.ws + CW_BAR; bar_.x = xb_xcc_id(); bar_.st = (volatile LAS unsigned*)(F.lds + MISC_OFF) + 8; xcd_barrier(bar_); } while (0)

#ifdef PROBE_T
    unsigned long long tacc_ = 0, t0_ = 0;
#define TSTART(id) do { if (PROBE_T == (id)) t0_ = rt(); } while (0)
#define TSTOP(id) do { if (PROBE_T == (id)) tacc_ += rt() - t0_; } while (0)
#define TSPIN() do { if (blockIdx.x == 0) { const unsigned long long ts_ = rt(); while (rt() - ts_ < tacc_) __builtin_amdgcn_s_sleep(8); } } while (0)
#else
#define TSTART(id) do {} while (0)
#define TSTOP(id) do {} while (0)
#define TSPIN() do {} while (0)
#endif
    const int G = F.G, c = (int)blockIdx.x, H = G / 2;
    char* ldsg = (char*)lds + RING_OFF;
    TSTART(1); phase_prologue(F);
    {
        int tid_ = threadIdx.x; asm volatile("" : "+v"(tid_)); const int plane = tid_ & 63, pwave = __builtin_amdgcn_readfirstlane(tid_ >> 6);
        weight_prep(F, 0, c * NWAVES + pwave, G * NWAVES, 0, 1, pwave, plane, 1);
        if (G == 256) { if (c >= 192) weight_prep(F, 0, 0, 1, (c - 192) * 512 + tid_, 64 * 512, pwave, plane, 2); }
        else weight_prep(F, 0, 0, 1, c * 512 + tid_, G * 512, pwave, plane, 2);
    }
    GRID_BAR();
    for (int u = threadIdx.x; u < 3072; u += NWAVES * 64) ((LAS float*)(F.lds + ROPE_LDS_OFF))[u] = u < 1024 ? F.ROPE()[u] : u < 2048 ? -F.ROPE()[u] : F.ROPE()[u - 1024];
    {
        int tid_ = threadIdx.x; asm volatile("" : "+v"(tid_)); const int plane = tid_ & 63, pwave = __builtin_amdgcn_readfirstlane(tid_ >> 6);
        weight_prep(F, 0, c * NWAVES + pwave, G * NWAVES, c * 512 + tid_, G * 512, pwave, plane, 4);
        int w0, wn; even_share(NCTX, G, c, w0, wn);
        stream_rows(F, 0, 0, w0, wn);
    }
    chain_step(F, CW_CHC, CW_CHL, 0u); TSTOP(1);
    for (int h = 0; h < 8 * DEPTH; ++h) {
        const int s = h >> 1, l = s >> 2, ph = s & 3; const bool isC = (h & 1) != 0; const int kind = (ph + (isC ? 1 : 0)) & 3;
        const int cw = isC ? CW_CHC : CW_CHL; const bool lat = !isC;
        const int pm0 = lat ? 32 : 0, rows = lat ? NLAT : NCTX;
        if (kind == 0) {
            if (lat) {
                int w0, wn;
                if (G == 256) { if (c < 128) { w0 = c * 48; wn = 48; } else if (c < 192) { w0 = 6144 + (c - 128) * 32; wn = 32; } else { w0 = 8192 + (c - 192) * 128; wn = 128; } } else even_share(NLAT, G, c, w0, wn);
                stream_rows(F, l, NCTX, w0, wn);
            } else {
                int w0, wn; even_share(NCTX, G, c, w0, wn); stream_rows(F, l + 1, 0, w0, wn);
                if (l + 1 < DEPTH) { int tid_ = threadIdx.x; asm volatile("" : "+v"(tid_)); const int plane = tid_ & 63, pwave = __builtin_amdgcn_readfirstlane(tid_ >> 6);
                    weight_prep(F, l + 1, c * NWAVES + pwave, G * NWAVES, c * 512 + tid_, G * 512, pwave, plane); }
            }
        } else if (kind == 1) {
            pg8::Gemm g{F.ACT(), F.WIN(l), rows, NPROJ, DM, DM}; pg8::StaticOrder S; S.init(rows, NPROJ, G, c, pm0);
            pg8::EpiInProj E{F.ws, F.out, l};
            pg8::gemm_phase<pg8::EpiInProj, pg8::StaticOrder, true, true>(F.lds + RING_OFF, g, S, E);
        } else if (kind == 2) {
            mix_list(F, l, lat, ldsg);
        } else {
            pg8::Gemm g{F.PROJ() + C_Z, F.WOUT(l), rows, DM, DM, LDP}; pg8::StaticOrder S; S.init(rows, DM, G, c, pm0);
            pg8::EpiDelta E{F.ws, l};
            pg8::gemm_phase<pg8::EpiDelta, pg8::StaticOrder, true, true>(F.lds + RING_OFF, g, S, E);
        }
        { const int hn = h + 1; chain_step(F, cw, (hn & 1) ? CW_CHC : CW_CHL, hn == 8 * DEPTH ? (unsigned)(4 * DEPTH) : (unsigned)((hn >> 1) + (hn & 1))); }
    }
    TSTART(6); { int w0, wn; even_share(NLAT, G, c, w0, wn); stream_rows(F, DEPTH, NCTX, w0, wn); } TSTOP(6);
    TSPIN();
#undef GRID_BAR
}

extern "C" void kernel_launch(void* const* d_in, const int* in_sizes, int n_in, void* d_out, int out_size, void* d_ws, size_t ws_size, hipStream_t stream) {
    static int grid = 0;
    if (grid == 0) {
        if (n_in != 21 || ws_size < WS_END) { fprintf(stderr, "kernel_launch: built for 21 inputs and >= %zu bytes of workspace; got n_in %d, ws %zu\n", (size_t)WS_END, n_in, ws_size); grid = -1; return; }
        int dev = 0, cus = 0, per_cu = 0;
        if (hipGetDevice(&dev) != hipSuccess || hipDeviceGetAttribute(&cus, hipDeviceAttributeMultiprocessorCount, dev) != hipSuccess) { grid = -1; return; }
        if (hipFuncSetAttribute((const void*)mk_fwd, hipFuncAttributeMaxDynamicSharedMemorySize, LDS_BYTES) != hipSuccess) { fprintf(stderr, "kernel_launch: hipFuncSetAttribute failed\n"); grid = -1; return; }
        if (hipOccupancyMaxActiveBlocksPerMultiprocessor(&per_cu, (const void*)mk_fwd, NWAVES * 64, LDS_BYTES) != hipSuccess || per_cu < 1) fprintf(stderr, "kernel_launch: occupancy query reports %d\n", per_cu);
        (void)hipGetLastError();
        grid = cus;
    }
    if (grid < 0) return;
    if (hipMemsetAsync((char*)d_ws + WS_CTL, 0, CTL_ZERO_BYTES, stream) != hipSuccess) return;
    Args a{};
    for (int i = 0; i < 21; ++i) a.in[i] = (const float*)d_in[i];
    a.out = (float*)d_out; a.ws = (unsigned char*)d_ws;
    hipLaunchKernelGGL(mk_fwd, dim3(grid), dim3(NWAVES * 64), LDS_BYTES, stream, a);
    const hipError_t le = hipPeekAtLastError();
    if (le != hipSuccess) fprintf(stderr, "kernel_launch: launch failed: %s\n", hipGetErrorName(le));
}
```
